# Optimizing an MI355X kernel written in HIP

```python
import jax, jax.numpy as jnp
from jax import lax
import numpy as np

D_MODEL = 1024
BATCH = 8
SEQ = 2048
DEPTH = 2
DEC_BATCH = 128
DEC_SEQ = 8
PAST_LEN = 16384
PAGE_SIZE = 128

N_RET_HEADS = 8
RET_DK = 64
RET_DV = 128
RET_QK = N_RET_HEADS * RET_DK
RET_V = N_RET_HEADS * RET_DV
RET_CHUNK = 128
ROPE_BASE = 10000.0
CONF_W = 512
CONF_K = 31
SC_W = 512
SC_K = 3
N_BRANCH = 3
D_FF = 2816
IN_COLS = 2 * RET_QK + 2 * RET_V + 2 * CONF_W + 3 * SC_W + N_BRANCH * D_MODEL
N_ADA = 9

kernel_name = "hybrid_retention_conformer_shortconv_step"


def rms_norm(x, g, eps=1e-6):
    xf = x.astype(jnp.float32)
    y = xf * lax.rsqrt(jnp.mean(xf * xf, axis=-1, keepdims=True) + eps)
    return (y * g.astype(jnp.float32)).astype(x.dtype)


def layer_norm(x, g, b, eps=1e-5):
    xf = x.astype(jnp.float32)
    mu = jnp.mean(xf, axis=-1, keepdims=True)
    var = jnp.mean(jnp.square(xf - mu), axis=-1, keepdims=True)
    y = (xf - mu) * lax.rsqrt(var + eps)
    return (y * g.astype(jnp.float32) + b.astype(jnp.float32)).astype(x.dtype)


def modulate(h, shift, scale):
    return h * (1.0 + scale) + shift


def swiglu(h, w1, w3, w2):
    return (jax.nn.silu(h @ w1) * (h @ w3)) @ w2


def rotary(x, pos):
    half = x.shape[-1] // 2
    freqs = ROPE_BASE ** (-jnp.arange(half, dtype=jnp.float32) / half)
    ang = pos[:, None] * freqs[None, :]
    cos = jnp.cos(ang)[None, :, None, :]
    sin = jnp.sin(ang)[None, :, None, :]
    x1, x2 = x[..., :half], x[..., half:]
    return jnp.concatenate([x1 * cos - x2 * sin, x1 * sin + x2 * cos], axis=-1)


def retention_log_gamma():
    return jnp.log(1.0 - jnp.exp2(-5.0 - jnp.arange(N_RET_HEADS, dtype=jnp.float32)))


def retention(q, k, v, S0, chunk):
    B, T, H, DK = q.shape
    DV = v.shape[-1]
    n = T // chunk
    lg = retention_log_gamma()
    idx = jnp.arange(chunk, dtype=jnp.float32)
    diff = idx[:, None] - idx[None, :]
    causal = diff >= 0
    decay = jnp.where(causal[None], jnp.exp(jnp.maximum(diff, 0.0)[None] * lg[:, None, None]), 0.0)
    q_decay = jnp.exp((idx + 1.0)[None, :] * lg[:, None]).T
    k_decay = jnp.exp((chunk - 1.0 - idx)[None, :] * lg[:, None])
    chunk_decay = jnp.exp(chunk * lg)

    def to_chunks(a):
        return a.reshape(B, n, chunk, H, a.shape[-1]).transpose(1, 0, 2, 3, 4)

    def step(S, inp):
        qc, kc, vc = inp
        scores = jnp.einsum('bihd,bjhd->bhij', qc, kc) * decay[None]
        o_intra = jnp.einsum('bhij,bjhe->bihe', scores, vc)
        o_cross = jnp.einsum('bihd,bhde->bihe', qc, S) * q_decay[None, :, :, None]
        S_new = S * chunk_decay[None, :, None, None] + jnp.einsum('bjhd,bjhe,hj->bhde', kc, vc, k_decay)
        return S_new, o_intra + o_cross

    S_fin, o = lax.scan(step, S0, (to_chunks(q), to_chunks(k), to_chunks(v)))
    o = o.transpose(1, 0, 2, 3, 4).reshape(B, T, H, DV)
    return o, S_fin


def head_group_norm(o, g, eps=1e-5):
    mu = jnp.mean(o, axis=-1, keepdims=True)
    var = jnp.mean(jnp.square(o - mu), axis=-1, keepdims=True)
    y = (o - mu) * lax.rsqrt(var + eps)
    B, T = o.shape[:2]
    return y.reshape(B, T, -1) * g.astype(jnp.float32)


def causal_dwconv(u, buf, w):
    K = w.shape[0]
    padded = jnp.concatenate([buf.astype(u.dtype), u], axis=1)
    out = lax.conv_general_dilated(
        padded, w[:, None, :].astype(u.dtype), window_strides=(1,), padding='VALID',
        dimension_numbers=('NWC', 'WIO', 'NWC'), feature_group_count=u.shape[-1])
    return out, padded[:, -(K - 1):]


def mixer(h, S0, conf_buf, sc_buf, pos0, w):
    B, T, _ = h.shape
    z = h @ w['w_in']
    sizes = [RET_QK, RET_QK, RET_V, RET_V, CONF_W, CONF_W, SC_W, SC_W, SC_W]
    splits = list(np.cumsum(sizes))
    q, k, v, g, ca, cb, sb, sc_c, sx, gl = jnp.split(z, splits, axis=-1)

    pos = pos0 + jnp.arange(T, dtype=jnp.float32)
    qf = rotary(q.astype(jnp.float32).reshape(B, T, N_RET_HEADS, RET_DK), pos) * (RET_DK ** -0.5)
    kf = rotary(k.astype(jnp.float32).reshape(B, T, N_RET_HEADS, RET_DK), pos)
    vf = v.astype(jnp.float32).reshape(B, T, N_RET_HEADS, RET_DV)
    chunk = RET_CHUNK if T % RET_CHUNK == 0 else T
    o, S_new = retention(qf, kf, vf, S0.astype(jnp.float32), chunk)
    o = head_group_norm(o, w['ret_gn_g']).astype(h.dtype)
    br_ret = (jax.nn.silu(g) * o) @ w['w_ret_out']

    u = ca * jax.nn.sigmoid(cb)
    cv, conf_new = causal_dwconv(u, conf_buf, w['conf_conv_w'])
    cv = layer_norm(cv + w['conf_conv_b'], w['conf_ln_g'], w['conf_ln_b'])
    br_conf = jax.nn.silu(cv) @ w['w_conf_out']

    us = sc_c * sx
    sv, sc_new = causal_dwconv(us, sc_buf, w['sc_conv_w'])
    br_sc = (sb * sv) @ w['w_sc_out']

    gates = jax.nn.sigmoid(gl + w['b_gate'])
    g_ret, g_conf, g_sc = jnp.split(gates, N_BRANCH, axis=-1)
    m = g_ret * br_ret + g_conf * br_conf + g_sc * br_sc
    return m @ w['w_o'], S_new.astype(S0.dtype), conf_new, sc_new


def trunk(x, c, state_ret, state_conf, state_sconv, pos0, p):
    rets, confs, scs = [], [], []
    for l in range(DEPTH):
        w = {name: arr[l] for name, arr in p.items() if name != 'g_final'}
        ada = jax.nn.silu(c) @ w['w_ada'] + w['b_ada']
        ada = ada[:, None, :]
        sh1, sc1, gt1, sh2, sc2, gt2, sh3, sc3, gt3 = jnp.split(ada, N_ADA, axis=-1)
        h = modulate(rms_norm(x, w['g_ffn1']), sh1, sc1)
        x = x + 0.5 * gt1 * swiglu(h, w['w1_a'], w['w3_a'], w['w2_a'])
        h = modulate(rms_norm(x, w['g_mix']), sh2, sc2)
        mo, S_new, conf_new, sc_new = mixer(h, state_ret[l], state_conf[l], state_sconv[l], pos0, w)
        x = x + gt2 * mo
        h = modulate(rms_norm(x, w['g_ffn2']), sh3, sc3)
        x = x + 0.5 * gt3 * swiglu(h, w['w1_b'], w['w3_b'], w['w2_b'])
        rets.append(S_new); confs.append(conf_new); scs.append(sc_new)
    y = rms_norm(x, p['g_final'])
    return y, jnp.stack(rets), jnp.stack(confs), jnp.stack(scs)


def setup_inputs(seed: int = 0) -> dict:
    key = jax.random.key(seed)
    ks = iter(jax.random.split(key, 64))
    f32 = jnp.float32

    def nrm(shape, scale):
        return jax.random.normal(next(ks), shape, f32) * scale

    def gain(shape):
        return 1.0 + 0.1 * jax.random.normal(next(ks), shape, f32)

    D, L = D_MODEL, DEPTH
    return {
        "x_prompt": nrm((BATCH, SEQ, D), 1.0),
        "x_sample": nrm((DEC_BATCH, DEC_SEQ, D), 1.0),
        "c_prompt": nrm((BATCH, D), 1.0),
        "c_sample": nrm((DEC_BATCH, D), 1.0),
        "state_ret": nrm((L, DEC_BATCH, N_RET_HEADS, RET_DK, RET_DV), 1.0),
        "state_conf": nrm((L, DEC_BATCH, CONF_K - 1, CONF_W), 1.0),
        "state_sconv": nrm((L, DEC_BATCH, SC_K - 1, SC_W), 1.0),
        "w_ada": nrm((L, D, N_ADA * D), 0.5 * D ** -0.5),
        "b_ada": nrm((L, N_ADA * D), 0.01),
        "g_ffn1": gain((L, D)),
        "w1_a": nrm((L, D, D_FF), D ** -0.5),
        "w3_a": nrm((L, D, D_FF), D ** -0.5),
        "w2_a": nrm((L, D_FF, D), D_FF ** -0.5),
        "g_mix": gain((L, D)),
        "w_in": nrm((L, D, IN_COLS), D ** -0.5),
        "b_gate": nrm((L, N_BRANCH * D), 0.01),
        "ret_gn_g": gain((L, RET_V)),
        "w_ret_out": nrm((L, RET_V, D), RET_V ** -0.5),
        "conf_conv_w": nrm((L, CONF_K, CONF_W), CONF_K ** -0.5),
        "conf_conv_b": nrm((L, CONF_W), 0.01),
        "conf_ln_g": gain((L, CONF_W)),
        "conf_ln_b": nrm((L, CONF_W), 0.01),
        "w_conf_out": nrm((L, CONF_W, D), CONF_W ** -0.5),
        "sc_conv_w": nrm((L, SC_K, SC_W), SC_K ** -0.5),
        "w_sc_out": nrm((L, SC_W, D), SC_W ** -0.5),
        "w_o": nrm((L, D, D), D ** -0.5),
        "g_ffn2": gain((L, D)),
        "w1_b": nrm((L, D, D_FF), D ** -0.5),
        "w3_b": nrm((L, D, D_FF), D ** -0.5),
        "w2_b": nrm((L, D_FF, D), D_FF ** -0.5),
        "g_final": gain((D,)),
    }


def reference(x_prompt, x_sample, c_prompt, c_sample, state_ret, state_conf, state_sconv,
              w_ada, b_ada, g_ffn1, w1_a, w3_a, w2_a, g_mix, w_in, b_gate, ret_gn_g, w_ret_out,
              conf_conv_w, conf_conv_b, conf_ln_g, conf_ln_b, w_conf_out, sc_conv_w, w_sc_out, w_o,
              g_ffn2, w1_b, w3_b, w2_b, g_final):
    p = dict(w_ada=w_ada, b_ada=b_ada, g_ffn1=g_ffn1, w1_a=w1_a, w3_a=w3_a, w2_a=w2_a,
             g_mix=g_mix, w_in=w_in, b_gate=b_gate, ret_gn_g=ret_gn_g, w_ret_out=w_ret_out,
             conf_conv_w=conf_conv_w, conf_conv_b=conf_conv_b, conf_ln_g=conf_ln_g,
             conf_ln_b=conf_ln_b, w_conf_out=w_conf_out, sc_conv_w=sc_conv_w, w_sc_out=w_sc_out,
             w_o=w_o, g_ffn2=g_ffn2, w1_b=w1_b, w3_b=w3_b, w2_b=w2_b, g_final=g_final)
    B = x_prompt.shape[0]
    ret0 = jnp.zeros((DEPTH, B, N_RET_HEADS, RET_DK, RET_DV), state_ret.dtype)
    conf0 = jnp.zeros((DEPTH, B, CONF_K - 1, CONF_W), x_prompt.dtype)
    sc0 = jnp.zeros((DEPTH, B, SC_K - 1, SC_W), x_prompt.dtype)
    y_prompt, ret_p, conf_p, sc_p = trunk(x_prompt, c_prompt, ret0, conf0, sc0, 0, p)
    y_sample, ret_s, conf_s, sc_s = trunk(x_sample, c_sample, state_ret, state_conf, state_sconv, PAST_LEN, p)
    return (y_prompt, y_sample, ret_p, ret_s, conf_p, conf_s, sc_p, sc_s)
```

```cpp
#include <hip/hip_runtime.h>
#include <hip/hip_cooperative_groups.h>
#include <cstdio>
#include <cstdint>
namespace cg = cooperative_groups;
namespace pg8 {
#define PG8_LAS __attribute__((address_space(3)))
typedef unsigned short bf16_t;
typedef short bf16x8 __attribute__((ext_vector_type(8)));
typedef float f32x4 __attribute__((ext_vector_type(4)));
typedef unsigned u32x4 __attribute__((ext_vector_type(4)));
constexpr int BM = 256, BK = 64, HALF = 128, HTB = HALF * BK * 2  , STAGE_BYTES = 8 * HTB, NXCD = 8, WGM = 8;

__host__ __device__ __forceinline__ int lds_byte(int r, int c) { const int st = (r >> 4) * 2 + (c >> 5), rr = r & 15, cc = c & 31, ob = rr * 64 + cc * 2; return st * 1024 + (ob ^ (((ob >> 9) & 1) << 5)); }
__host__ __device__ __forceinline__ void stage_rc(int b, int& R, int& C) { const int st = b / 1024, sb = b % 1024, swz = sb ^ (((sb >> 9) & 1) << 5); R = (st >> 1) * 16 + swz / 64; C = (st & 1) * 32 + (swz % 64) / 2; }
__host__ __device__ __forceinline__ int perm32(int rho) { const int n = rho >> 4, i = rho & 15; return 8 * (i >> 2) + 4 * n + (i & 3); }

struct Unit { int pm, pn; };
struct Gemm { const bf16_t* A; const bf16_t* Bt; int M, N, K, lda, ldb; };

struct StaticOrder {
    int nM, nN, nwg, G, c;
    __host__ __device__ void init(int M, int N, int G_, int c_) { nM = M / BM; nN = N / BM; nwg = nM * nN; G = G_; c = c_; }
    __host__ __device__ bool next(int i, Unit& u) const {
        const long L = (long)i * G + c; if (L >= nwg) return false;
        int wgid = (int)L; { const int q = nwg / NXCD, r = nwg % NXCD, xcd = wgid % NXCD, off = wgid / NXCD; wgid = (xcd < r ? xcd * (q + 1) : r * (q + 1) + (xcd - r) * q) + off; }
        const int nig = WGM * nN, gid = wgid / nig, fm = gid * WGM, gsz = (nM - fm) < WGM ? (nM - fm) : WGM;
        u.pm = fm + ((wgid % nig) % gsz); u.pn = (wgid % nig) / gsz; return true;
    }
    __device__ __forceinline__ void a_ready(const Unit&) const {}
    __device__ __forceinline__ void done(const Unit&) const {}
};


__device__ __forceinline__ unsigned cvt_pk_bf16(float lo, float hi) { unsigned r; asm volatile("v_cvt_pk_bf16_f32 %0, %1, %2" : "=v"(r) : "v"(lo), "v"(hi)); return r; }
typedef float f32x2 __attribute__((ext_vector_type(2)));

template <class Epi, class Sched, bool ALIGN_EPI = false, bool SP2 = false>
__device__ __forceinline__ void gemm_phase(PG8_LAS unsigned char* lds, const Gemm g, const Sched& S, const Epi& E) {
    int tid_ = threadIdx.x; asm volatile("" : "+v"(tid_)); const int tid = tid_, wid = __builtin_amdgcn_readfirstlane(tid >> 6), lane = tid & 63, wr = wid >> 2, wc = wid & 3, fr = lane & 15, fq = lane >> 4;
    const int K = g.K, nt = K / BK;
    unsigned voffA[2], voffB[2];
#pragma unroll
    for (int i = 0; i < 2; ++i) { int R, C; stage_rc(tid * 16 + i * 8192, R, C); const int Rb = Epi::PERM ? ((R & ~31) + perm32(R & 31)) : R;
        voffA[i] = (unsigned)(R * g.lda + C) * 2u; voffB[i] = (unsigned)(Rb * g.ldb + C) * 2u; }
    const size_t kstep = (size_t)(BK * 2);
    const size_t hstepA = (size_t)HALF * g.lda * 2, hstepB = (size_t)HALF * g.ldb * 2;
    const size_t tstepA = 2 * hstepA, tstepB = 2 * hstepB;
    const unsigned ldsw = (unsigned)wid * 1024u;
    const int aoff = lds_byte(wr * 64 + fr, fq * 8), boff = lds_byte(wc * 32 + fr, fq * 8);
#define PG8_SA(b, h) (((b) * 2 + (h)) * HTB)
#define PG8_SB(b, h) ((4 + (b) * 2 + (h)) * HTB)
#define PG8_STAGE(bufoff, gbase, voff) do { _Pragma("unroll") for (int _i = 0; _i < 2; ++_i) \
        __builtin_amdgcn_global_load_lds((const unsigned*)((const char*)(gbase) + (voff)[_i]), (PG8_LAS unsigned*)(lds + (bufoff) + ldsw + _i * 8192), 16, 0, 0); } while (0)
#define PG8_LDA(dst, b, h) do { _Pragma("unroll") for (int m = 0; m < 4; ++m) _Pragma("unroll") for (int k = 0; k < 2; ++k) dst[m][k] = *(const PG8_LAS bf16x8*)(lds + PG8_SA(b, h) + aoff + m * 2048 + k * 1024); } while (0)
#define PG8_LDB(dst, b, h) do { _Pragma("unroll") for (int n = 0; n < 2; ++n) _Pragma("unroll") for (int k = 0; k < 2; ++k) dst[n][k] = *(const PG8_LAS bf16x8*)(lds + PG8_SB(b, h) + boff + n * 2048 + k * 1024); } while (0)
#define PG8_MMA(ai, bj, At, Bt) do { __builtin_amdgcn_s_setprio(1); _Pragma("unroll") for (int m = 0; m < 4; ++m) _Pragma("unroll") for (int n = 0; n < 2; ++n) _Pragma("unroll") for (int k = 0; k < 2; ++k) \
        acc[ai][bj][m][n] = __builtin_amdgcn_mfma_f32_16x16x32_bf16(Bt[n][k], At[m][k], acc[ai][bj][m][n], 0, 0, 0); __builtin_amdgcn_s_setprio(0); } while (0)
#define PG8_WAIT_V(n) asm volatile("s_waitcnt vmcnt(" #n ")" ::: "memory")
#define PG8_WAIT_L(n) asm volatile("s_waitcnt lgkmcnt(" #n ")" ::: "memory")
#define PG8_BAR __builtin_amdgcn_s_barrier()
#define PG8_SCHED __builtin_amdgcn_sched_barrier(0)
    Unit cur, nxt; int ui = 0;
    if (!S.next(0, cur)) return;
    f32x4 acc[2][2][4][2];
#pragma unroll
    for (int a = 0; a < 2; ++a)
#pragma unroll
        for (int b = 0; b < 2; ++b)
#pragma unroll
            for (int m = 0; m < 4; ++m)
#pragma unroll
                for (int n = 0; n < 2; ++n) acc[a][b][m][n] = (f32x4){0.f, 0.f, 0.f, 0.f};
    bf16x8 At[4][2], B0[2][2], B1[2][2];
    const char* cA = (const char*)g.A + (size_t)cur.pm * tstepA; const char* cB = (const char*)g.Bt + (size_t)cur.pn * tstepB;
    S.a_ready(cur);
    if constexpr (SP2) {
        PG8_STAGE(PG8_SB(0, 0), cB, voffB); PG8_STAGE(PG8_SB(0, 1), cB + hstepB, voffB); PG8_STAGE(PG8_SA(0, 0), cA, voffA); PG8_STAGE(PG8_SA(0, 1), cA + hstepA, voffA);
        if (wr == 1) PG8_BAR;
        PG8_WAIT_V(2); PG8_BAR;
        PG8_STAGE(PG8_SB(1, 0), cB + kstep, voffB); PG8_STAGE(PG8_SA(1, 0), cA + kstep, voffA); PG8_STAGE(PG8_SB(1, 1), cB + hstepB + kstep, voffB);
        PG8_WAIT_V(6); PG8_BAR;
    } else {
        PG8_STAGE(PG8_SB(0, 0), cB, voffB); PG8_STAGE(PG8_SA(0, 0), cA, voffA); PG8_STAGE(PG8_SB(0, 1), cB + hstepB, voffB); PG8_STAGE(PG8_SA(0, 1), cA + hstepA, voffA);
        if (wr == 1) PG8_BAR;
        PG8_WAIT_V(4); PG8_BAR;
        PG8_STAGE(PG8_SB(1, 0), cB + kstep, voffB); PG8_STAGE(PG8_SA(1, 0), cA + kstep, voffA); PG8_STAGE(PG8_SB(1, 1), cB + hstepB + kstep, voffB);
        PG8_WAIT_V(6); PG8_BAR;
    }
    for (;;) {
        const bool has_next = S.next(ui + 1, nxt);
        const char* nA = has_next ? (const char*)g.A + (size_t)nxt.pm * tstepA : cA; const char* nB = has_next ? (const char*)g.Bt + (size_t)nxt.pn * tstepB : cB;
        for (int t = 0; t < nt; t += 2) {
            const bool last = (t == nt - 2);
            const char* a1 = cA + (size_t)(t + 1) * kstep;
            const char* a2 = last ? nA : cA + (size_t)(t + 2) * kstep; const char* b2 = last ? nB : cB + (size_t)(t + 2) * kstep;
            const char* a3 = a2 + kstep; const char* b3 = b2 + kstep;
            if (last && has_next) S.a_ready(nxt);
            if constexpr (SP2) {
            PG8_LDB(B0, 0, 0); PG8_LDB(B1, 0, 1); PG8_SCHED; PG8_LDA(At, 0, 0); PG8_STAGE(PG8_SA(1, 1), a1 + hstepA, voffA);
            PG8_WAIT_V(8); PG8_WAIT_L(0); PG8_BAR; PG8_MMA(0, 0, At, B0); PG8_MMA(0, 1, At, B1); PG8_BAR; PG8_SCHED;
            PG8_LDA(At, 0, 1); PG8_STAGE(PG8_SB(0, 0), b2, voffB); PG8_STAGE(PG8_SB(0, 1), b2 + hstepB, voffB); PG8_STAGE(PG8_SA(0, 0), a2, voffA);
            PG8_WAIT_V(8); PG8_WAIT_L(0); PG8_BAR; PG8_MMA(1, 0, At, B0); PG8_MMA(1, 1, At, B1); PG8_BAR; PG8_SCHED;
            PG8_LDB(B0, 1, 0); PG8_LDB(B1, 1, 1); PG8_SCHED; PG8_LDA(At, 1, 0); PG8_STAGE(PG8_SA(0, 1), a2 + hstepA, voffA);
            PG8_WAIT_V(8); PG8_WAIT_L(0); PG8_BAR; PG8_MMA(0, 0, At, B0); PG8_MMA(0, 1, At, B1); PG8_BAR; PG8_SCHED;
            PG8_LDA(At, 1, 1); PG8_STAGE(PG8_SB(1, 0), b3, voffB); PG8_STAGE(PG8_SB(1, 1), b3 + hstepB, voffB); PG8_STAGE(PG8_SA(1, 0), a3, voffA);
            PG8_WAIT_V(8); PG8_WAIT_L(0); PG8_BAR; PG8_MMA(1, 0, At, B0); PG8_MMA(1, 1, At, B1); PG8_BAR; PG8_SCHED;
            } else {
            PG8_LDB(B0, 0, 0); PG8_SCHED; PG8_LDA(At, 0, 0); PG8_STAGE(PG8_SA(1, 1), a1 + hstepA, voffA);
            PG8_WAIT_L(8); PG8_BAR; PG8_WAIT_L(0); PG8_MMA(0, 0, At, B0); PG8_BAR; PG8_SCHED;
            PG8_LDB(B1, 0, 1); PG8_STAGE(PG8_SB(0, 0), b2, voffB);
            PG8_BAR; PG8_WAIT_L(0); PG8_MMA(0, 1, At, B1); PG8_BAR;
            PG8_LDA(At, 0, 1); PG8_STAGE(PG8_SA(0, 0), a2, voffA);
            PG8_BAR; PG8_WAIT_L(0); PG8_MMA(1, 0, At, B0); PG8_BAR; PG8_SCHED;
            PG8_STAGE(PG8_SB(0, 1), b2 + hstepB, voffB);
            PG8_WAIT_V(6); PG8_BAR; PG8_MMA(1, 1, At, B1); PG8_BAR;
            PG8_LDB(B0, 1, 0); PG8_SCHED; PG8_LDA(At, 1, 0); PG8_STAGE(PG8_SA(0, 1), a2 + hstepA, voffA);
            PG8_WAIT_L(8); PG8_BAR; PG8_WAIT_L(0); PG8_MMA(0, 0, At, B0); PG8_BAR; PG8_SCHED;
            PG8_LDB(B1, 1, 1); PG8_STAGE(PG8_SB(1, 0), b3, voffB);
            PG8_BAR; PG8_WAIT_L(0); PG8_MMA(0, 1, At, B1); PG8_BAR;
            PG8_LDA(At, 1, 1); PG8_STAGE(PG8_SA(1, 0), a3, voffA);
            PG8_BAR; PG8_WAIT_L(0); PG8_MMA(1, 0, At, B0); PG8_BAR; PG8_SCHED;
            PG8_STAGE(PG8_SB(1, 1), b3 + hstepB, voffB);
            PG8_WAIT_V(6); PG8_BAR; PG8_MMA(1, 1, At, B1); PG8_BAR;
            }
        }
        if constexpr (ALIGN_EPI) { if (wr == 0) PG8_BAR; }
        if constexpr (!Epi::AFTER_DRAIN) { E(acc, cur, wr, wc, fr, fq); S.done(cur); }
        if (!has_next) break;
#pragma unroll
        for (int a = 0; a < 2; ++a)
#pragma unroll
            for (int b = 0; b < 2; ++b)
#pragma unroll
                for (int m = 0; m < 4; ++m)
#pragma unroll
                    for (int n = 0; n < 2; ++n) acc[a][b][m][n] = (f32x4){0.f, 0.f, 0.f, 0.f};
        cur = nxt; cA = nA; cB = nB; ++ui;
        if constexpr (ALIGN_EPI) { if (wr == 1) PG8_BAR; }
    }
    PG8_WAIT_V(0);
    if constexpr (!ALIGN_EPI) { if (wr == 0) PG8_BAR; }
    PG8_BAR;
    if constexpr (Epi::AFTER_DRAIN) { E.fused(acc, cur, wr, wc, fr, fq, lds, wid, lane); S.done(cur); }
#undef PG8_SA
#undef PG8_SB
#undef PG8_STAGE
#undef PG8_LDA
#undef PG8_LDB
#undef PG8_MMA
#undef PG8_WAIT_V
#undef PG8_WAIT_L
#undef PG8_BAR
#undef PG8_SCHED
}
}
#ifndef PHASES
#define PHASES 0xFFFF
#endif

#define LAS __attribute__((address_space(3)))
typedef unsigned short bf16;
typedef float f32x4 __attribute__((ext_vector_type(4)));
typedef short bf16x8 __attribute__((ext_vector_type(8)));
typedef unsigned u32x4 __attribute__((ext_vector_type(4)));
typedef unsigned u32x2 __attribute__((ext_vector_type(2)));

constexpr int NPROMPT = 8 * 2048, NSAMPLE = 128 * 8, MTOK = NPROMPT + NSAMPLE;
constexpr int DM = 1024, DFF = 2816, NADA = 9216, NSEQ = 136, INCOLS = 8704;
constexpr int NTHREADS = 512, NWAVES = 8;

constexpr size_t MiB = 1u << 20;
constexpr size_t WS_ADA = 0, WS_CSIL = 10 * MiB, WS_ROPE = 11 * MiB;
constexpr size_t WS_W13A = 12 * MiB, WS_W2A = 23 * MiB, WS_W13B = 29 * MiB, WS_W2B = 40 * MiB, WS_WIN = 46 * MiB;
constexpr size_t WS_WRET = 63 * MiB, WS_WCONF = 65 * MiB, WS_WSC = 66 * MiB, WS_WO = 67 * MiB;
constexpr size_t WS_H = 69 * MiB;
constexpr size_t WS_Z = 103 * MiB;
constexpr size_t WS_Q = WS_Z, WS_K = WS_Z + 17 * MiB, WS_V = WS_Z + 34 * MiB, WS_G = WS_Z + 68 * MiB;
constexpr size_t WS_CA = WS_Z + 102 * MiB, WS_CB = WS_Z + 119 * MiB, WS_SB = WS_Z + 136 * MiB, WS_SCC = WS_Z + 153 * MiB, WS_SX = WS_Z + 170 * MiB;
constexpr size_t WS_GL = WS_Z + 187 * MiB;
constexpr size_t WS_END = WS_GL + 102 * MiB;
constexpr size_t WS_U = WS_Z;
constexpr size_t WS_WADA = WS_Z;
constexpr size_t WS_M32 = WS_CA;
constexpr size_t WS_MBF = WS_V;

constexpr size_t O_Y = 0, O_RETP = 17825792, O_RETS = 18874368, O_CONFP = 35651584, O_CONFS = 35897344, O_SCP = 39829504, O_SCS = 39845888, O_END = 40108032;

constexpr int LDS_BYTES = 147456;

__device__ __forceinline__ unsigned f2bf(float f) { unsigned u = __builtin_bit_cast(unsigned, f); return (u + 0x7fffu + ((u >> 16) & 1u)) >> 16; }
__device__ __forceinline__ unsigned pk2(float lo, float hi) { return f2bf(lo) | (f2bf(hi) << 16); }
__device__ __forceinline__ float bf2f(unsigned b) { return __builtin_bit_cast(float, b << 16); }
__device__ __forceinline__ float bflo(unsigned w) { return __builtin_bit_cast(float, w << 16); }
__device__ __forceinline__ float bfhi(unsigned w) { return __builtin_bit_cast(float, w & 0xffff0000u); }
__device__ __forceinline__ float sigmoidf_(float x) { return __builtin_amdgcn_rcpf(1.0f + __expf(-x)); }
__device__ __forceinline__ float siluf_(float x) { return x * sigmoidf_(x); }
__device__ __forceinline__ int seq_of_row(int row) { return row < NPROMPT ? (row >> 11) : 8 + ((row - NPROMPT) >> 3); }
__device__ __forceinline__ float wave_sum(float v) {
#pragma unroll
    for (int o = 1; o < 64; o <<= 1) v += __shfl_xor(v, o);
    return v;
}
__device__ __forceinline__ float lgamma_h(int h) {
    float r = -0.0317486983145803f;
    r = h == 1 ? -0.015748356968139168f : r; r = h == 2 ? -0.007843177461025893f : r; r = h == 3 ? -0.003913899321136329f : r;
    r = h == 4 ? -0.0019550348358033506f : r; r = h == 5 ? -0.0009770396478266127f : r; r = h == 6 ? -0.0004884004981088745f : r; r = h == 7 ? -0.0002441704321739145f : r;
    return r;
}

using pg8::Unit;
struct EpiSwiglu {
    static constexpr bool PERM = true, AFTER_DRAIN = false;
    bf16* U;
    __device__ __forceinline__ void operator()(const f32x4 (&acc)[2][2][4][2], const Unit& u, int wr, int wc, int fr, int fq) const {
        const int row0 = u.pm * 256 + wr * 64 + fr, ucol0 = u.pn * 128 + wc * 16 + 4 * fq;
#pragma unroll
        for (int ai = 0; ai < 2; ++ai)
#pragma unroll
            for (int m = 0; m < 4; ++m) { bf16* rowp = U + (size_t)(row0 + ai * 128 + m * 16) * DFF + ucol0;
#pragma unroll
                for (int bj = 0; bj < 2; ++bj) { const f32x4 v0 = acc[ai][bj][m][0], v1 = acc[ai][bj][m][1];
                    u32x2 w; w.x = pk2(siluf_(v0[0]) * v1[0], siluf_(v0[1]) * v1[1]); w.y = pk2(siluf_(v0[2]) * v1[2], siluf_(v0[3]) * v1[3]);
                    *(u32x2*)(rowp + bj * 64) = w; } }
    }
};
struct EpiResid {
    static constexpr bool PERM = false, AFTER_DRAIN = false;
    float* x; const float* gate; float coef;
    __device__ __forceinline__ void operator()(const f32x4 (&acc)[2][2][4][2], const Unit& u, int wr, int wc, int fr, int fq) const {
        const int col0 = u.pn * 256 + wc * 32 + 4 * fq;
#pragma unroll
        for (int ai = 0; ai < 2; ++ai)
#pragma unroll
            for (int m = 0; m < 4; ++m) { const int row = u.pm * 256 + ai * 128 + wr * 64 + m * 16 + fr; const float* gp = gate + (size_t)seq_of_row(row) * NADA + col0; float* xp = x + (size_t)row * DM + col0;
#pragma unroll
                for (int bj = 0; bj < 2; ++bj)
#pragma unroll
                    for (int n = 0; n < 2; ++n) { const int c = bj * 128 + n * 16; const f32x4 g4 = *(const f32x4*)(gp + c); const f32x4 xv = *(const f32x4*)(xp + c);
                        *(f32x4*)(xp + c) = xv + acc[ai][bj][m][n] * g4 * coef; } }
    }
};
template <int MODE> struct EpiBranch {
    static constexpr bool PERM = false, AFTER_DRAIN = false;
    const bf16* GL; const float* bgate; float* M32; bf16* MBF; int br;
    __device__ __forceinline__ void operator()(const f32x4 (&acc)[2][2][4][2], const Unit& u, int wr, int wc, int fr, int fq) const {
        const int col0 = u.pn * 256 + wc * 32 + 4 * fq;
#pragma unroll
        for (int ai = 0; ai < 2; ++ai)
#pragma unroll
            for (int m = 0; m < 4; ++m) { const int row = u.pm * 256 + ai * 128 + wr * 64 + m * 16 + fr;
#pragma unroll
                for (int bj = 0; bj < 2; ++bj)
#pragma unroll
                    for (int n = 0; n < 2; ++n) { const int c = col0 + bj * 128 + n * 16;
                        const u32x2 gw = *(const u32x2*)(GL + (size_t)row * 3072 + br * 1024 + c); const f32x4 bg = *(const f32x4*)(bgate + br * 1024 + c);
                        f32x4 g; g[0] = sigmoidf_(bflo(gw.x) + bg[0]); g[1] = sigmoidf_(bfhi(gw.x) + bg[1]); g[2] = sigmoidf_(bflo(gw.y) + bg[2]); g[3] = sigmoidf_(bfhi(gw.y) + bg[3]);
                        f32x4 v = g * acc[ai][bj][m][n];
                        float* mp = M32 + (size_t)row * DM + c;
                        if (MODE == 0) { *(f32x4*)mp = v; }
                        else if (MODE == 1) { *(f32x4*)mp = *(const f32x4*)mp + v; }
                        else { v = v + *(const f32x4*)mp; u32x2 w; w.x = pk2(v[0], v[1]); w.y = pk2(v[2], v[3]); *(u32x2*)(MBF + (size_t)row * DM + c) = w; } } }
    }
};
struct EpiWin {
    static constexpr bool PERM = true, AFTER_DRAIN = false;
    unsigned char* ws;
    __device__ __forceinline__ void operator()(const f32x4 (&acc)[2][2][4][2], const Unit& u, int wr, int wc, int fr, int fq) const {
        const int colt = u.pn * 256; size_t off; int ld, c0;
        if (colt < 512) { off = WS_Q; ld = 512; c0 = colt; }
        else if (colt < 1024) { off = WS_K; ld = 512; c0 = colt - 512; }
        else if (colt < 2048) { off = WS_V; ld = 1024; c0 = colt - 1024; }
        else if (colt < 3072) { off = WS_G; ld = 1024; c0 = colt - 2048; }
        else if (colt < 3584) { off = WS_CA; ld = 512; c0 = colt - 3072; }
        else if (colt < 4096) { off = WS_CB; ld = 512; c0 = colt - 3584; }
        else if (colt < 4608) { off = WS_SB; ld = 512; c0 = colt - 4096; }
        else if (colt < 5120) { off = WS_SCC; ld = 512; c0 = colt - 4608; }
        else if (colt < 5632) { off = WS_SX; ld = 512; c0 = colt - 5120; }
        else { off = WS_GL; ld = 3072; c0 = colt - 5632; }
        bf16* base = (bf16*)(ws + off);
        const int row0 = u.pm * 256 + wr * 64 + fr, col0 = c0 + wc * 32 + 8 * fq;
#pragma unroll
        for (int ai = 0; ai < 2; ++ai)
#pragma unroll
            for (int m = 0; m < 4; ++m) { bf16* rowp = base + (size_t)(row0 + ai * 128 + m * 16) * ld + col0;
#pragma unroll
                for (int bj = 0; bj < 2; ++bj) { const f32x4 v0 = acc[ai][bj][m][0], v1 = acc[ai][bj][m][1];
                    u32x4 w; w.x = pk2(v0[0], v0[1]); w.y = pk2(v0[2], v0[3]); w.z = pk2(v1[0], v1[1]); w.w = pk2(v1[2], v1[3]);
                    *(u32x4*)(rowp + bj * 128) = w; } }
    }
};
struct EpiAda {
    static constexpr bool PERM = false, AFTER_DRAIN = false;
    float* ADA; const float* bada;
    __device__ __forceinline__ void operator()(const f32x4 (&acc)[2][2][4][2], const Unit& u, int wr, int wc, int fr, int fq) const {
        const int l = u.pn / 36, col0 = (u.pn - l * 36) * 256 + wc * 32 + 4 * fq;
#pragma unroll
        for (int ai = 0; ai < 2; ++ai)
#pragma unroll
            for (int m = 0; m < 4; ++m) { const int row = ai * 128 + wr * 64 + m * 16 + fr;
                if (row < NSEQ) {
#pragma unroll
                    for (int bj = 0; bj < 2; ++bj)
#pragma unroll
                        for (int n = 0; n < 2; ++n) { const int c = col0 + bj * 128 + n * 16;
                            *(f32x4*)(ADA + ((size_t)l * NSEQ + row) * NADA + c) = acc[ai][bj][m][n] + *(const f32x4*)(bada + (size_t)l * NADA + c); } } }
    }
};

__device__ __forceinline__ void transpose_item(const float* W, int N, bf16* WT, int ldk, int mode, int row_off, LAS float* scr, int item, int lane) {
    const int nblk = N / 32, kb = item / nblk, nb = item % nblk, k0 = 64 * kb, n0 = 32 * nb;
#pragma unroll 8
    for (int i = 0; i < 32; ++i) { const int kk = 2 * i + (lane >> 5); scr[kk * 33 + (lane & 31)] = W[(size_t)(k0 + kk) * N + n0 + (lane & 31)]; }
    asm volatile("s_waitcnt lgkmcnt(0)" ::: "memory");
    const int c = lane & 7;
#pragma unroll
    for (int j = 0; j < 4; ++j) { const int n = (lane >> 3) + 8 * j; const LAS float* s = scr + (8 * c) * 33 + n; const int ng = n0 + n;
        const int row = mode == 0 ? row_off + ng : (((ng >> 2) << 3) + (mode == 2 ? 4 : 0) + (ng & 3));
        u32x4 o; o.x = pk2(s[0 * 33], s[1 * 33]); o.y = pk2(s[2 * 33], s[3 * 33]); o.z = pk2(s[4 * 33], s[5 * 33]); o.w = pk2(s[6 * 33], s[7 * 33]);
        *(u32x4*)(WT + (size_t)row * ldk + k0 + 8 * c) = o; }
    asm volatile("s_waitcnt lgkmcnt(0)" ::: "memory");
}

struct Args { const float* in[31]; float* out; unsigned char* ws; };
typedef const __attribute__((address_space(4))) Args* ArgsP;

#define CONV(Wp, Kk, Nn, WTp, ldk, mode, roff) { const int cnt_ = ((Kk) / 64) * ((Nn) / 32); if (r < cnt_) { transpose_item((Wp), (Nn), (WTp), (ldk), (mode), (roff), scr, r, lane); continue; } r -= cnt_; }
constexpr int LAYER_CONV_ITEMS = 6 * 1408 + 4352 + 512 + 256 + 256 + 512;
__device__ __forceinline__ void convert_layer_weights(ArgsP ap, unsigned char* ws, int l, LAS unsigned char* lds, int gw, int NGW, int wave, int lane) {
    LAS float* scr = (LAS float*)(lds + wave * 16384);
    const size_t ffo = (size_t)l * DM * DFF;
    for (int it = gw; it < LAYER_CONV_ITEMS; it += NGW) {
        int r = it;
        CONV(ap->in[10] + ffo, 1024, 2816, (bf16*)(ws + WS_W13A), 1024, 1, 0)
        CONV(ap->in[11] + ffo, 1024, 2816, (bf16*)(ws + WS_W13A), 1024, 2, 0)
        CONV(ap->in[12] + ffo, 2816, 1024, (bf16*)(ws + WS_W2A), 2816, 0, 0)
        CONV(ap->in[27] + ffo, 1024, 2816, (bf16*)(ws + WS_W13B), 1024, 1, 0)
        CONV(ap->in[28] + ffo, 1024, 2816, (bf16*)(ws + WS_W13B), 1024, 2, 0)
        CONV(ap->in[29] + ffo, 2816, 1024, (bf16*)(ws + WS_W2B), 2816, 0, 0)
        CONV(ap->in[14] + (size_t)l * DM * INCOLS, 1024, 8704, (bf16*)(ws + WS_WIN), 1024, 0, 0)
        CONV(ap->in[17] + (size_t)l * 1024 * 1024, 1024, 1024, (bf16*)(ws + WS_WRET), 1024, 0, 0)
        CONV(ap->in[22] + (size_t)l * 512 * 1024, 512, 1024, (bf16*)(ws + WS_WCONF), 512, 0, 0)
        CONV(ap->in[24] + (size_t)l * 512 * 1024, 512, 1024, (bf16*)(ws + WS_WSC), 512, 0, 0)
        transpose_item(ap->in[25] + (size_t)l * 1024 * 1024, 1024, (bf16*)(ws + WS_WO), 1024, 0, 0, scr, r, lane);
    }
}
__device__ __forceinline__ void convert_ada_weights(ArgsP ap, unsigned char* ws, LAS unsigned char* lds, int gw, int NGW, int wave, int lane) {
    LAS float* scr = (LAS float*)(lds + wave * 16384);
    for (int it = gw; it < 2 * 4608; it += NGW) { const int l = it / 4608, r = it - l * 4608;
        transpose_item(ap->in[7] + (size_t)l * DM * NADA, NADA, (bf16*)(ws + WS_WADA), 1024, 0, l * NADA, scr, r, lane); }
}

__device__ __forceinline__ void rmsmod_phase(const float* xp, const float* xs, float* xcopy, const float* gnorm, const float* ada_l, int sidx, bf16* H, int gw, int NGW, int lane) {
    for (int m = gw; m < MTOK; m += NGW) {
        const float* xrow = m < NPROMPT ? xp + (size_t)m * DM : xs + (size_t)(m - NPROMPT) * DM;
        const f32x4* xr = (const f32x4*)xrow + lane;
        f32x4 v[4]; float s = 0.f;
#pragma unroll
        for (int j = 0; j < 4; ++j) { v[j] = xr[64 * j]; s += (v[j][0] * v[j][0] + v[j][1] * v[j][1]) + (v[j][2] * v[j][2] + v[j][3] * v[j][3]); }
        const float rstd = 1.0f / sqrtf(wave_sum(s) * (1.f / DM) + 1e-6f);
        const float* sh = ada_l + (size_t)seq_of_row(m) * NADA + sidx * 1024; const float* sc = sh + 1024;
        if (xcopy) { f32x4* xc = (f32x4*)(xcopy + (size_t)m * DM) + lane;
#pragma unroll
            for (int j = 0; j < 4; ++j) xc[64 * j] = v[j]; }
        u32x2* o8 = (u32x2*)(H + (size_t)m * DM) + lane;
#pragma unroll
        for (int j = 0; j < 4; ++j) { const int c = 4 * (lane + 64 * j);
            const f32x4 g4 = *(const f32x4*)(gnorm + c), s4 = *(const f32x4*)(sh + c), c4 = *(const f32x4*)(sc + c);
            const f32x4 o = v[j] * rstd * g4 * (c4 + 1.0f) + s4;
            u32x2 w; w.x = pk2(o[0], o[1]); w.y = pk2(o[2], o[3]); o8[64 * j] = w; }
    }
}
__device__ __forceinline__ void final_norm_phase(float* x, const float* g, int gw, int NGW, int lane) {
    for (int m = gw; m < MTOK; m += NGW) {
        f32x4* xr = (f32x4*)(x + (size_t)m * DM) + lane;
        f32x4 v[4]; float s = 0.f;
#pragma unroll
        for (int j = 0; j < 4; ++j) { v[j] = xr[64 * j]; s += (v[j][0] * v[j][0] + v[j][1] * v[j][1]) + (v[j][2] * v[j][2] + v[j][3] * v[j][3]); }
        const float rstd = 1.0f / sqrtf(wave_sum(s) * (1.f / DM) + 1e-6f);
#pragma unroll
        for (int j = 0; j < 4; ++j) { const f32x4 g4 = *(const f32x4*)(g + 4 * (lane + 64 * j)); xr[64 * j] = v[j] * rstd * g4; }
    }
}

#define MFMA16(a, b, c) __builtin_amdgcn_mfma_f32_16x16x32_bf16((a), (b), (c), 0, 0, 0)
constexpr int RS64 = 72, RS128 = 136;
constexpr int L_QS = 0, L_KS = 18432, L_KT = 36864, L_VT = 54272, L_PS = 89088, L_ST = 123904;

__device__ __forceinline__ void ret_prompt_unit(LAS unsigned char* lds, const bf16* Q, const bf16* K, const bf16* V, bf16* G, const float* rope, const float* gn_g, float* Sout, int b, int h, int tid) {
    LAS bf16* Qs = (LAS bf16*)(lds + L_QS); LAS bf16* Ks = (LAS bf16*)(lds + L_KS); LAS bf16* KTs = (LAS bf16*)(lds + L_KT);
    LAS bf16* VTs = (LAS bf16*)(lds + L_VT); LAS bf16* Ps = (LAS bf16*)(lds + L_PS); LAS bf16* STs = (LAS bf16*)(lds + L_ST);
    const int w = __builtin_amdgcn_readfirstlane(tid >> 6), lane = tid & 63, l15 = lane & 15, q4 = lane >> 4;
    const float lg = lgamma_h(h);
    for (int i = tid; i < 128 * RS64 / 2; i += NTHREADS) ((LAS unsigned*)STs)[i] = 0u;
    f32x4 S[4];
#pragma unroll
    for (int x = 0; x < 4; ++x) S[x] = (f32x4){0.f, 0.f, 0.f, 0.f};
    const float gam = __expf(lg), cd = __expf(128.f * lg), g127 = __expf(127.f * lg);
    const int dt = w & 3, et0 = (w >> 2) * 4;
    for (int c = 0; c < 16; ++c) {
        const int row0 = b * 2048 + c * 128;
        {
            const int i = tid >> 2, gq = tid & 3; const size_t rb = (size_t)(row0 + i) * 512 + h * 64 + 8 * gq;
            const u32x4 qlo = *(const u32x4*)(Q + rb), qhi = *(const u32x4*)(Q + rb + 32), klo = *(const u32x4*)(K + rb), khi = *(const u32x4*)(K + rb + 32);
            const f32x4* rp = (const f32x4*)(rope + ((size_t)(c * 128 + i) * 32 + 8 * gq) * 2);
            const f32x4 r0 = rp[0], r1 = rp[1], r2 = rp[2], r3 = rp[3];
            const float cs[8] = {r0[0], r0[2], r1[0], r1[2], r2[0], r2[2], r3[0], r3[2]}, sn[8] = {r0[1], r0[3], r1[1], r1[3], r2[1], r2[3], r3[1], r3[3]};
            const unsigned ql[4] = {qlo.x, qlo.y, qlo.z, qlo.w}, qh[4] = {qhi.x, qhi.y, qhi.z, qhi.w}, kl[4] = {klo.x, klo.y, klo.z, klo.w}, kh[4] = {khi.x, khi.y, khi.z, khi.w};
            const float gi = __expf((float)i * lg) * 0.125f, gk = __expf(-(float)i * lg);
            float qa[8], qb[8], ka[8], kb[8];
#pragma unroll
            for (int x = 0; x < 8; ++x) {
                const float q1 = (x & 1) ? bfhi(ql[x >> 1]) : bflo(ql[x >> 1]), q2 = (x & 1) ? bfhi(qh[x >> 1]) : bflo(qh[x >> 1]);
                const float k1 = (x & 1) ? bfhi(kl[x >> 1]) : bflo(kl[x >> 1]), k2 = (x & 1) ? bfhi(kh[x >> 1]) : bflo(kh[x >> 1]);
                qa[x] = (q1 * cs[x] - q2 * sn[x]) * gi; qb[x] = (q1 * sn[x] + q2 * cs[x]) * gi;
                ka[x] = (k1 * cs[x] - k2 * sn[x]) * gk; kb[x] = (k1 * sn[x] + k2 * cs[x]) * gk;
            }
            u32x4 t;
            t.x = pk2(qa[0], qa[1]); t.y = pk2(qa[2], qa[3]); t.z = pk2(qa[4], qa[5]); t.w = pk2(qa[6], qa[7]); *(LAS u32x4*)(Qs + i * RS64 + 8 * gq) = t;
            t.x = pk2(qb[0], qb[1]); t.y = pk2(qb[2], qb[3]); t.z = pk2(qb[4], qb[5]); t.w = pk2(qb[6], qb[7]); *(LAS u32x4*)(Qs + i * RS64 + 32 + 8 * gq) = t;
            t.x = pk2(ka[0], ka[1]); t.y = pk2(ka[2], ka[3]); t.z = pk2(ka[4], ka[5]); t.w = pk2(ka[6], ka[7]); *(LAS u32x4*)(Ks + i * RS64 + 8 * gq) = t;
            t.x = pk2(kb[0], kb[1]); t.y = pk2(kb[2], kb[3]); t.z = pk2(kb[4], kb[5]); t.w = pk2(kb[6], kb[7]); *(LAS u32x4*)(Ks + i * RS64 + 32 + 8 * gq) = t;
#pragma unroll
            for (int x = 0; x < 8; ++x) { KTs[(8 * gq + x) * RS128 + i] = (bf16)f2bf(ka[x]); KTs[(32 + 8 * gq + x) * RS128 + i] = (bf16)f2bf(kb[x]); }
        }
        {
            const int j = tid >> 2;
#pragma unroll
            for (int y = 0; y < 4; ++y) { const int e0 = 32 * (tid & 3) + 8 * y; const u32x4 vv = *(const u32x4*)(V + (size_t)(row0 + j) * 1024 + h * 128 + e0);
                const unsigned vw[4] = {vv.x, vv.y, vv.z, vv.w};
#pragma unroll
                for (int x = 0; x < 8; ++x) VTs[(e0 + x) * RS128 + j] = (bf16)((x & 1) ? (vw[x >> 1] >> 16) : (vw[x >> 1] & 0xffffu)); }
        }
        __syncthreads();
        const bf16x8 aq0 = *(const LAS bf16x8*)(Qs + (16 * w + l15) * RS64 + 8 * q4), aq1 = *(const LAS bf16x8*)(Qs + (16 * w + l15) * RS64 + 32 + 8 * q4);
        const int jt_hi = w | 1;
        for (int jt = 0; jt <= jt_hi; ++jt) {
            const bf16x8 b0 = *(const LAS bf16x8*)(Ks + (16 * jt + l15) * RS64 + 8 * q4), b1 = *(const LAS bf16x8*)(Ks + (16 * jt + l15) * RS64 + 32 + 8 * q4);
            f32x4 s = (f32x4){0.f, 0.f, 0.f, 0.f}; s = MFMA16(aq0, b0, s); s = MFMA16(aq1, b1, s);
            const int j = 16 * jt + l15;
#pragma unroll
            for (int r = 0; r < 4; ++r) { const int i = 16 * w + 4 * q4 + r; Ps[i * RS128 + j] = (bf16)f2bf(j <= i ? s[r] : 0.f); }
        }
        f32x4 o[8];
#pragma unroll
        for (int et = 0; et < 8; ++et) o[et] = (f32x4){0.f, 0.f, 0.f, 0.f};
        for (int ks = 0; ks <= (w >> 1); ++ks) {
            const bf16x8 a = *(const LAS bf16x8*)(Ps + (16 * w + l15) * RS128 + 32 * ks + 8 * q4);
#pragma unroll
            for (int et = 0; et < 8; ++et) { const bf16x8 bb = *(const LAS bf16x8*)(VTs + (16 * et + l15) * RS128 + 32 * ks + 8 * q4); o[et] = MFMA16(a, bb, o[et]); }
        }
#pragma unroll
        for (int ks = 0; ks < 2; ++ks) { const bf16x8 a = ks ? aq1 : aq0;
#pragma unroll
            for (int et = 0; et < 8; ++et) { const bf16x8 bb = *(const LAS bf16x8*)(STs + (16 * et + l15) * RS64 + 32 * ks + 8 * q4); o[et] = MFMA16(a, bb, o[et]); } }
#pragma unroll
        for (int r = 0; r < 4; ++r) {
            float s = 0.f;
#pragma unroll
            for (int et = 0; et < 8; ++et) s += o[et][r];
            s += __shfl_xor(s, 1); s += __shfl_xor(s, 2); s += __shfl_xor(s, 4); s += __shfl_xor(s, 8);
            const float mean = s * (1.f / 128.f); float vs = 0.f;
#pragma unroll
            for (int et = 0; et < 8; ++et) { const float d = o[et][r] - mean; vs += d * d; }
            vs += __shfl_xor(vs, 1); vs += __shfl_xor(vs, 2); vs += __shfl_xor(vs, 4); vs += __shfl_xor(vs, 8);
            const float rstd = 1.0f / sqrtf(vs * (1.f / 128.f) + 1e-5f);
            bf16* gp = G + (size_t)(row0 + 16 * w + 4 * q4 + r) * 1024 + h * 128 + l15;
#pragma unroll
            for (int et = 0; et < 8; ++et) { const float y = (o[et][r] - mean) * rstd * gn_g[h * 128 + 16 * et + l15]; const float gv = bf2f(gp[16 * et]); gp[16 * et] = (bf16)f2bf(siluf_(gv) * y); }
        }
        f32x4 kv[4];
#pragma unroll
        for (int x = 0; x < 4; ++x) kv[x] = (f32x4){0.f, 0.f, 0.f, 0.f};
#pragma unroll
        for (int ks = 0; ks < 4; ++ks) { const bf16x8 a = *(const LAS bf16x8*)(KTs + (16 * dt + l15) * RS128 + 32 * ks + 8 * q4);
#pragma unroll
            for (int x = 0; x < 4; ++x) { const bf16x8 bb = *(const LAS bf16x8*)(VTs + (16 * (et0 + x) + l15) * RS128 + 32 * ks + 8 * q4); kv[x] = MFMA16(a, bb, kv[x]); } }
#pragma unroll
        for (int x = 0; x < 4; ++x) S[x] = S[x] * cd + kv[x] * g127;
        __syncthreads();
#pragma unroll
        for (int x = 0; x < 4; ++x) { u32x2 t; t.x = pk2(gam * S[x][0], gam * S[x][1]); t.y = pk2(gam * S[x][2], gam * S[x][3]);
            *(LAS u32x2*)(STs + (16 * (et0 + x) + l15) * RS64 + 16 * dt + 4 * q4) = t; }
    }
#pragma unroll
    for (int x = 0; x < 4; ++x)
#pragma unroll
        for (int r = 0; r < 4; ++r) Sout[(16 * dt + 4 * q4 + r) * 128 + 16 * (et0 + x) + l15] = S[x][r];
    __syncthreads();
}

__device__ __forceinline__ void ret_sample_unit(LAS unsigned char* lds, const bf16* Q, const bf16* K, const bf16* V, bf16* G, const float* rope, const float* gn_g, const float* S0, float* Sout, int bs, int h, int tid) {
    LAS float* qf = (LAS float*)lds; LAS float* kf = qf + 512; LAS float* vf = kf + 512; LAS float* sc = vf + 1024; LAS float* oc = sc + 64; LAS float* ob = oc + 4096;
    const int w = tid >> 6, lane = tid & 63; const float lg = lgamma_h(h); const int row0 = NPROMPT + bs * 8;
    {   const int which = tid >> 8, t2 = tid & 255, i = t2 >> 5, d = t2 & 31; const bf16* src = which ? K : Q; const size_t rb = (size_t)(row0 + i) * 512 + h * 64 + d;
        const float x1 = bf2f(src[rb]), x2 = bf2f(src[rb + 32]); const float cs = rope[((size_t)(2048 + i) * 32 + d) * 2], sn = rope[((size_t)(2048 + i) * 32 + d) * 2 + 1];
        const float scale = which ? 1.0f : 0.125f; LAS float* dst = which ? kf : qf;
        dst[i * 64 + d] = (x1 * cs - x2 * sn) * scale; dst[i * 64 + 32 + d] = (x1 * sn + x2 * cs) * scale; }
#pragma unroll
    for (int y = 0; y < 2; ++y) { const int idx = tid + 512 * y, j = idx >> 7, e = idx & 127; vf[idx] = bf2f(V[(size_t)(row0 + j) * 1024 + h * 128 + e]); }
    __syncthreads();
    if (tid < 64) { const int i = tid >> 3, j = tid & 7; float s = 0.f;
        if (j <= i) { for (int d = 0; d < 64; ++d) s += qf[i * 64 + d] * kf[j * 64 + d]; s *= __expf((float)(i - j) * lg); }
        sc[tid] = s; }
    const int e = tid & 127, dg = tid >> 7;
    float Sreg[16];
#pragma unroll
    for (int dd = 0; dd < 16; ++dd) Sreg[dd] = S0[(dg * 16 + dd) * 128 + e];
#pragma unroll
    for (int i = 0; i < 8; ++i) { float p = 0.f;
#pragma unroll
        for (int dd = 0; dd < 16; ++dd) p += qf[i * 64 + dg * 16 + dd] * Sreg[dd];
        oc[(dg * 8 + i) * 128 + e] = p; }
    const float g8 = __expf(8.f * lg);
    float vdec[8];
#pragma unroll
    for (int j = 0; j < 8; ++j) vdec[j] = __expf((float)(7 - j) * lg) * vf[j * 128 + e];
#pragma unroll
    for (int dd = 0; dd < 16; ++dd) { float acc = Sreg[dd] * g8;
#pragma unroll
        for (int j = 0; j < 8; ++j) acc += kf[j * 64 + dg * 16 + dd] * vdec[j];
        Sout[(dg * 16 + dd) * 128 + e] = acc; }
    __syncthreads();
#pragma unroll
    for (int y = 0; y < 2; ++y) { const int idx = tid + 512 * y, i = idx >> 7, ee = idx & 127;
        float o = (oc[(0 + i) * 128 + ee] + oc[(8 + i) * 128 + ee] + oc[(16 + i) * 128 + ee] + oc[(24 + i) * 128 + ee]) * __expf((float)(i + 1) * lg);
        for (int j = 0; j <= i; ++j) o += sc[i * 8 + j] * vf[j * 128 + ee];
        ob[idx] = o; }
    __syncthreads();
    {   const int i = w; const float v0 = ob[i * 128 + lane], v1 = ob[i * 128 + 64 + lane];
        const float mean = wave_sum(v0 + v1) * (1.f / 128.f); const float d0 = v0 - mean, d1 = v1 - mean;
        const float rstd = 1.0f / sqrtf(wave_sum(d0 * d0 + d1 * d1) * (1.f / 128.f) + 1e-5f);
        bf16* gp = G + (size_t)(row0 + i) * 1024 + h * 128 + lane;
        const float g0 = bf2f(gp[0]), g1 = bf2f(gp[64]);
        gp[0] = (bf16)f2bf(siluf_(g0) * d0 * rstd * gn_g[h * 128 + lane]); gp[64] = (bf16)f2bf(siluf_(g1) * d1 * rstd * gn_g[h * 128 + 64 + lane]); }
    __syncthreads();
}

template <int NT> __device__ __forceinline__ void conf_unit(LAS unsigned char* lds, const bf16* CA, const bf16* CB, bf16* XCS, const float* cw, const float* cbias, const float* lng, const float* lnb,
                                                             const float* state, float* state_out, int seqrow0, int t0, int T, int tid) {
    LAS float* U = (LAS float*)lds; LAS float* CV = U + 46 * 512;
    const int c = tid, w = tid >> 6, lane = tid & 63;
    for (int r = 0; r < 30 + NT; ++r) {
        float u;
        if (state && r < 30) u = state[r * 512 + c];
        else { const int t = t0 - 30 + r;
            if (t < 0) u = 0.f;
            else { const size_t gi = (size_t)(seqrow0 + t) * 512 + c; u = bf2f(CA[gi]) * sigmoidf_(bf2f(CB[gi]));
                if (!state && r >= 30 && t >= T - 30) state_out[(t - (T - 30)) * 512 + c] = u; } }
        U[r * 512 + c] = u;
    }
    if (state) { for (int rr = 0; rr < 30; ++rr) state_out[rr * 512 + c] = U[(rr + NT) * 512 + c]; }
    float cv[NT]; const float bias = cbias[c];
#pragma unroll
    for (int tt = 0; tt < NT; ++tt) cv[tt] = bias;
    for (int k = 0; k < 31; ++k) { const float wk = cw[k * 512 + c];
#pragma unroll
        for (int tt = 0; tt < NT; ++tt) cv[tt] += wk * U[(tt + k) * 512 + c]; }
#pragma unroll
    for (int tt = 0; tt < NT; ++tt) CV[tt * 512 + c] = cv[tt];
    __syncthreads();
    for (int tt = w; tt < NT; tt += 8) {
        const f32x4 x0 = *(const LAS f32x4*)(CV + tt * 512 + lane * 8), x1 = *(const LAS f32x4*)(CV + tt * 512 + lane * 8 + 4);
        const float mean = wave_sum((x0[0] + x0[1]) + (x0[2] + x0[3]) + (x1[0] + x1[1]) + (x1[2] + x1[3])) * (1.f / 512.f);
        const f32x4 d0 = x0 - mean, d1 = x1 - mean;
        const float var = wave_sum((d0[0] * d0[0] + d0[1] * d0[1]) + (d0[2] * d0[2] + d0[3] * d0[3]) + (d1[0] * d1[0] + d1[1] * d1[1]) + (d1[2] * d1[2] + d1[3] * d1[3])) * (1.f / 512.f);
        const float rstd = 1.0f / sqrtf(var + 1e-5f);
        const f32x4 g0 = *(const f32x4*)(lng + lane * 8), g1 = *(const f32x4*)(lng + lane * 8 + 4), b0 = *(const f32x4*)(lnb + lane * 8), b1 = *(const f32x4*)(lnb + lane * 8 + 4);
        const f32x4 y0 = d0 * rstd * g0 + b0, y1 = d1 * rstd * g1 + b1;
        u32x4 o; o.x = pk2(siluf_(y0[0]), siluf_(y0[1])); o.y = pk2(siluf_(y0[2]), siluf_(y0[3])); o.z = pk2(siluf_(y1[0]), siluf_(y1[1])); o.w = pk2(siluf_(y1[2]), siluf_(y1[3]));
        *(u32x4*)(XCS + (size_t)(seqrow0 + t0 + tt) * 1024 + lane * 8) = o;
    }
    __syncthreads();
}

__device__ __forceinline__ void sconv_unit(const bf16* SB, const bf16* SCC, const bf16* SX, bf16* XCS, const float* scw, const float* state_l  , float* outp_l  , float* outs_l  , int tile, int tid) {
#pragma unroll 1
    for (int y = 0; y < 8; ++y) {
        const int item = tid + 512 * y, R = tile * 64 + (item >> 6), c0 = (item & 63) * 8;
        const bool prompt = R < NPROMPT; const int t = prompt ? (R & 2047) : ((R - NPROMPT) & 7); const int sq = prompt ? (R >> 11) : ((R - NPROMPT) >> 3);
        float us[3][8];
#pragma unroll
        for (int k = 0; k < 3; ++k) { const int tp = t - 2 + k;
            if (tp >= 0) { const size_t gi = (size_t)(R - 2 + k) * 512 + c0; const u32x4 a = *(const u32x4*)(SCC + gi), bq = *(const u32x4*)(SX + gi);
                const unsigned aw[4] = {a.x, a.y, a.z, a.w}, bw[4] = {bq.x, bq.y, bq.z, bq.w};
#pragma unroll
                for (int x = 0; x < 4; ++x) { us[k][2 * x] = bflo(aw[x]) * bflo(bw[x]); us[k][2 * x + 1] = bfhi(aw[x]) * bfhi(bw[x]); } }
            else if (prompt) {
#pragma unroll
                for (int x = 0; x < 8; ++x) us[k][x] = 0.f; }
            else { const float* sp = state_l + ((size_t)sq * 2 + (2 + tp)) * 512 + c0; const f32x4 s0 = *(const f32x4*)sp, s1 = *(const f32x4*)(sp + 4);
#pragma unroll
                for (int x = 0; x < 4; ++x) { us[k][x] = s0[x]; us[k][4 + x] = s1[x]; } } }
        const u32x4 sbv = *(const u32x4*)(SB + (size_t)R * 512 + c0); const unsigned sw[4] = {sbv.x, sbv.y, sbv.z, sbv.w};
        float o[8];
#pragma unroll
        for (int x = 0; x < 8; ++x) { const float sv = scw[c0 + x] * us[0][x] + scw[512 + c0 + x] * us[1][x] + scw[1024 + c0 + x] * us[2][x];
            o[x] = ((x & 1) ? bfhi(sw[x >> 1]) : bflo(sw[x >> 1])) * sv; }
        u32x4 ow; ow.x = pk2(o[0], o[1]); ow.y = pk2(o[2], o[3]); ow.z = pk2(o[4], o[5]); ow.w = pk2(o[6], o[7]);
        *(u32x4*)(XCS + (size_t)R * 1024 + 512 + c0) = ow;
        const int tl = prompt ? 2046 : 6;
        if (t >= tl) { float* op = (prompt ? outp_l : outs_l) + ((size_t)sq * 2 + (t - tl)) * 512 + c0;
            *(f32x4*)op = (f32x4){us[2][0], us[2][1], us[2][2], us[2][3]}; *(f32x4*)(op + 4) = (f32x4){us[2][4], us[2][5], us[2][6], us[2][7]}; }
    }
}

__global__ void __launch_bounds__(NTHREADS, 2) mega_fwd(Args a) {
    extern __shared__ __attribute__((aligned(16))) unsigned char lds_raw[];
    cg::grid_group grid = cg::this_grid();
    LAS unsigned char* lds = (LAS unsigned char*)lds_raw;
    const int G = gridDim.x, bid0 = blockIdx.x, NGW = G * NWAVES;
#define PHASE_BEGIN ArgsP ap = (ArgsP)__builtin_amdgcn_kernarg_segment_ptr(); asm volatile("" : "+s"(ap)); unsigned char* ws = ap->ws; float* XW = ap->out; int tid = threadIdx.x; asm volatile("" : "+v"(tid)); int bid = bid0; asm volatile("" : "+s"(bid)); \
    const int lane = tid & 63, wave = __builtin_amdgcn_readfirstlane(tid >> 6), gw = bid * NWAVES + wave; \
    float* ADA = (float*)(ws + WS_ADA); float* ROPE = (float*)(ws + WS_ROPE); bf16* H = (bf16*)(ws + WS_H); bf16* U = (bf16*)(ws + WS_U); \
    (void)lane; (void)wave; (void)gw; (void)ADA; (void)ROPE; (void)H; (void)U; (void)XW;
#define GEMM_PHASE(EPI, Aptr, Bptr, Mm, Nn, Kk, lda_, ldb_, ...) { pg8::Gemm g{(const bf16*)(Aptr), (const bf16*)(Bptr), (Mm), (Nn), (Kk), (lda_), (ldb_)}; pg8::StaticOrder S; S.init((Mm), (Nn), G, bid); \
        EPI E{__VA_ARGS__}; pg8::gemm_phase<EPI, pg8::StaticOrder, true, true>(lds, g, S, E); }

    {   PHASE_BEGIN
#if PHASES & 1
        convert_ada_weights(ap, ws, lds, gw, NGW, wave, lane);
#endif
        bf16* CS = (bf16*)(ws + WS_CSIL);
        for (int i = bid * NTHREADS + tid; i < 256 * 1024; i += G * NTHREADS) { const int r = i >> 10, c = i & 1023; float v = 0.f;
            if (r < 8) v = siluf_(ap->in[2][r * 1024 + c]); else if (r < NSEQ) v = siluf_(ap->in[3][(r - 8) * 1024 + c]);
            CS[i] = (bf16)f2bf(v); }
        for (int i = bid * NTHREADS + tid; i < 2056 * 32; i += G * NTHREADS) { const int p = i >> 5, k = i & 31; const int pos = p < 2048 ? p : 16384 + (p - 2048);
            double f = 0.15915494309189535; for (int q = 0; q < k; ++q) f *= 0.7498942093324559;
            double rv = (double)pos * f; rv -= __builtin_floor(rv); const float fr = (float)rv;
            ROPE[2 * i] = __builtin_amdgcn_cosf(fr); ROPE[2 * i + 1] = __builtin_amdgcn_sinf(fr); }
#if PHASES & 1
        convert_layer_weights(ap, ws, 0, lds, gw, NGW, wave, lane);
#endif
    }
    grid.sync();
    {   PHASE_BEGIN
#if PHASES & 1024
        GEMM_PHASE(EpiAda, ws + WS_CSIL, ws + WS_WADA, 256, 2 * NADA, 1024, 1024, 1024, ADA, ap->in[8])
#endif
    }
    grid.sync();

#pragma unroll 1
    for (int l = 0; l < 2; ++l) {
        {   PHASE_BEGIN
            const float* ada_l = ADA + (size_t)l * NSEQ * NADA;
            if (l == 0) rmsmod_phase(ap->in[0], ap->in[1], XW, ap->in[9], ada_l, 0, H, gw, NGW, lane);
            else { rmsmod_phase(XW, XW + (size_t)NPROMPT * DM, nullptr, ap->in[9] + l * DM, ada_l, 0, H, gw, NGW, lane);
#if PHASES & 1
                convert_layer_weights(ap, ws, l, lds, gw, NGW, wave, lane);
#endif
            } }
        grid.sync();
        {   PHASE_BEGIN
#if PHASES & 2
            GEMM_PHASE(EpiSwiglu, H, ws + WS_W13A, MTOK, 2 * DFF, 1024, 1024, 1024, U)
#endif
        }
        grid.sync();
        {   PHASE_BEGIN
            const float* ada_l = ADA + (size_t)l * NSEQ * NADA;
#if PHASES & 4
            GEMM_PHASE(EpiResid, U, ws + WS_W2A, MTOK, DM, DFF, DFF, DFF, XW, ada_l + 2 * 1024, 0.5f)
#endif
        }
        grid.sync();
        {   PHASE_BEGIN
            const float* ada_l = ADA + (size_t)l * NSEQ * NADA;
            rmsmod_phase(XW, XW + (size_t)NPROMPT * DM, nullptr, ap->in[13] + l * DM, ada_l, 3, H, gw, NGW, lane); }
        grid.sync();
        {   PHASE_BEGIN
#if PHASES & 16
            GEMM_PHASE(EpiWin, H, ws + WS_WIN, MTOK, INCOLS, 1024, 1024, 1024, ws)
#endif
        }
        grid.sync();
        {
            PHASE_BEGIN
            const bf16* Qb = (const bf16*)(ws + WS_Q); const bf16* Kb = (const bf16*)(ws + WS_K); const bf16* Vb = (const bf16*)(ws + WS_V); bf16* Gb = (bf16*)(ws + WS_G);
            bf16* XCS = H; float* out = XW;
            const float* gn_g = ap->in[16] + l * 1024;
            if (bid < 64) {
#if PHASES & 32
                ret_prompt_unit(lds, Qb, Kb, Vb, Gb, ROPE, gn_g, out + O_RETP + ((size_t)l * 64 + bid) * 8192, bid >> 3, bid & 7, tid);
#endif
            } else {
                const int nb = G - 64;
#pragma unroll 1
                for (int u = bid - 64; u < 1024 + 1024 + 128 + 272; u += nb) {
                    if (u < 1024) { const int bs = u >> 3, h = u & 7;
#if PHASES & 64
                        ret_sample_unit(lds, Qb, Kb, Vb, Gb, ROPE, gn_g, ap->in[4] + (((size_t)l * 128 + bs) * 8 + h) * 8192, out + O_RETS + (((size_t)l * 128 + bs) * 8 + h) * 8192, bs, h, tid);
#endif
                    } else if (u < 2048) { const int v = u - 1024, b = v >> 7, ti = v & 127;
#if PHASES & 128
                        conf_unit<16>(lds, (const bf16*)(ws + WS_CA), (const bf16*)(ws + WS_CB), XCS, ap->in[18] + l * 31 * 512, ap->in[19] + l * 512, ap->in[20] + l * 512, ap->in[21] + l * 512,
                                      nullptr, out + O_CONFP + ((size_t)l * 8 + b) * 30 * 512, b * 2048, ti * 16, 2048, tid);
#endif
                    } else if (u < 2176) { const int bs = u - 2048;
#if PHASES & 128
                        conf_unit<8>(lds, (const bf16*)(ws + WS_CA), (const bf16*)(ws + WS_CB), XCS, ap->in[18] + l * 31 * 512, ap->in[19] + l * 512, ap->in[20] + l * 512, ap->in[21] + l * 512,
                                     ap->in[5] + ((size_t)l * 128 + bs) * 30 * 512, out + O_CONFS + ((size_t)l * 128 + bs) * 30 * 512, NPROMPT + bs * 8, 0, 8, tid);
#endif
                    } else {
#if PHASES & 256
                        sconv_unit((const bf16*)(ws + WS_SB), (const bf16*)(ws + WS_SCC), (const bf16*)(ws + WS_SX), XCS, ap->in[23] + l * 3 * 512, ap->in[6] + (size_t)l * 128 * 2 * 512,
                                   out + O_SCP + (size_t)l * 8 * 2 * 512, out + O_SCS + (size_t)l * 128 * 2 * 512, u - 2176, tid);
#endif
                    }
                }
            }
        }
        grid.sync();
#if PHASES & 512
        {   PHASE_BEGIN
            GEMM_PHASE(EpiBranch<0>, ws + WS_G, ws + WS_WRET, MTOK, DM, 1024, 1024, 1024, (const bf16*)(ws + WS_GL), ap->in[15] + l * 3072, (float*)(ws + WS_M32), (bf16*)(ws + WS_MBF), 0) }
#endif
        grid.sync();
#if PHASES & 512
        {   PHASE_BEGIN
            GEMM_PHASE(EpiBranch<1>, H, ws + WS_WCONF, MTOK, DM, 512, 1024, 512, (const bf16*)(ws + WS_GL), ap->in[15] + l * 3072, (float*)(ws + WS_M32), (bf16*)(ws + WS_MBF), 1) }
#endif
        grid.sync();
#if PHASES & 512
        {   PHASE_BEGIN
            GEMM_PHASE(EpiBranch<2>, H + 512, ws + WS_WSC, MTOK, DM, 512, 1024, 512, (const bf16*)(ws + WS_GL), ap->in[15] + l * 3072, (float*)(ws + WS_M32), (bf16*)(ws + WS_MBF), 2) }
#endif
        grid.sync();
        {   PHASE_BEGIN
            const float* ada_l = ADA + (size_t)l * NSEQ * NADA;
#if PHASES & 4
            GEMM_PHASE(EpiResid, ws + WS_MBF, ws + WS_WO, MTOK, DM, 1024, 1024, 1024, XW, ada_l + 5 * 1024, 1.0f)
#endif
        }
        grid.sync();
        {   PHASE_BEGIN
            const float* ada_l = ADA + (size_t)l * NSEQ * NADA;
            rmsmod_phase(XW, XW + (size_t)NPROMPT * DM, nullptr, ap->in[26] + l * DM, ada_l, 6, H, gw, NGW, lane); }
        grid.sync();
        {   PHASE_BEGIN
#if PHASES & 2
            GEMM_PHASE(EpiSwiglu, H, ws + WS_W13B, MTOK, 2 * DFF, 1024, 1024, 1024, U)
#endif
        }
        grid.sync();
        {   PHASE_BEGIN
            const float* ada_l = ADA + (size_t)l * NSEQ * NADA;
#if PHASES & 4
            GEMM_PHASE(EpiResid, U, ws + WS_W2B, MTOK, DM, DFF, DFF, DFF, XW, ada_l + 8 * 1024, 0.5f)
#endif
        }
        grid.sync();
    }
    {   PHASE_BEGIN
        final_norm_phase(XW, ap->in[30], gw, NGW, lane); }
}

extern "C" void kernel_launch(void* const* d_in, const int* in_sizes, int n_in, void* d_out, int out_size, void* d_ws, size_t ws_size, hipStream_t stream) {
    static int grid = 0;
    if (grid == 0) {
        if (n_in != 31 || out_size != (int)O_END || ws_size < WS_END) { fprintf(stderr, "kernel_launch: unexpected shapes (n_in %d, out %d, ws %zu)\n", n_in, out_size, ws_size); grid = -1; return; }
        int dev = 0, cus = 0, per_cu = 0;
        if (hipGetDevice(&dev) != hipSuccess || hipDeviceGetAttribute(&cus, hipDeviceAttributeMultiprocessorCount, dev) != hipSuccess) { grid = -1; return; }
        if (hipFuncSetAttribute((const void*)mega_fwd, hipFuncAttributeMaxDynamicSharedMemorySize, LDS_BYTES) != hipSuccess) { fprintf(stderr, "kernel_launch: hipFuncSetAttribute failed\n"); grid = -1; return; }
        if (hipOccupancyMaxActiveBlocksPerMultiprocessor(&per_cu, (const void*)mega_fwd, NTHREADS, LDS_BYTES) != hipSuccess || per_cu < 1) { fprintf(stderr, "kernel_launch: occupancy query failed (%d)\n", per_cu); (void)hipGetLastError(); grid = -1; return; }
        grid = cus * per_cu;
        if (grid < 128) { fprintf(stderr, "kernel_launch: grid %d too small\n", grid); grid = -1; return; }
    }
    if (grid < 0) return;
    Args a{};
    for (int i = 0; i < 31; ++i) a.in[i] = (const float*)d_in[i];
    a.out = (float*)d_out; a.ws = (unsigned char*)d_ws;
    void* args[] = {&a};
    hipError_t e = hipLaunchCooperativeKernel((const void*)mega_fwd, dim3(grid), dim3(NTHREADS), args, LDS_BYTES, stream);
    if (e != hipSuccess) fprintf(stderr, "kernel_launch: cooperative launch failed: %s (grid %d)\n", hipGetErrorString(e), grid);
}
```

```cpp
#include <hip/hip_runtime.h>
#include <hip/hip_cooperative_groups.h>
#include <cstdio>
#include <cstdint>
namespace cg = cooperative_groups;
namespace pg8 {
#define PG8_LAS __attribute__((address_space(3)))
typedef unsigned short bf16_t;
typedef short bf16x8 __attribute__((ext_vector_type(8)));
typedef float f32x4 __attribute__((ext_vector_type(4)));
typedef unsigned u32x4 __attribute__((ext_vector_type(4)));
constexpr int BM = 256, BK = 64, HALF = 128, HTB = HALF * BK * 2  , STAGE_BYTES = 8 * HTB, NXCD = 8, WGM = 8;

__host__ __device__ __forceinline__ int lds_byte(int r, int c) { const int st = (r >> 4) * 2 + (c >> 5), rr = r & 15, cc = c & 31, ob = rr * 64 + cc * 2; return st * 1024 + (ob ^ (((ob >> 9) & 1) << 5)); }
__host__ __device__ __forceinline__ void stage_rc(int b, int& R, int& C) { const int st = b / 1024, sb = b % 1024, swz = sb ^ (((sb >> 9) & 1) << 5); R = (st >> 1) * 16 + swz / 64; C = (st & 1) * 32 + (swz % 64) / 2; }
__host__ __device__ __forceinline__ int perm32(int rho) { const int n = rho >> 4, i = rho & 15; return 8 * (i >> 2) + 4 * n + (i & 3); }

struct Unit { int pm, pn; };
struct Gemm { const bf16_t* A; const bf16_t* Bt; int M, N, K, lda, ldb; };

struct StaticOrder {
    int nM, nN, nwg, G, c;
    __host__ __device__ void init(int M, int N, int G_, int c_) { nM = M / BM; nN = N / BM; nwg = nM * nN; G = G_; c = c_; }
    __host__ __device__ bool next(int i, Unit& u) const {
        const long L = (long)i * G + c; if (L >= nwg) return false;
        int wgid = (int)L; { const int q = nwg / NXCD, r = nwg % NXCD, xcd = wgid % NXCD, off = wgid / NXCD; wgid = (xcd < r ? xcd * (q + 1) : r * (q + 1) + (xcd - r) * q) + off; }
        const int nig = WGM * nN, gid = wgid / nig, fm = gid * WGM, gsz = (nM - fm) < WGM ? (nM - fm) : WGM;
        u.pm = fm + ((wgid % nig) % gsz); u.pn = (wgid % nig) / gsz; return true;
    }
    __device__ __forceinline__ void a_ready(const Unit&) const {}
    __device__ __forceinline__ void done(const Unit&) const {}
};


__device__ __forceinline__ unsigned cvt_pk_bf16(float lo, float hi) { unsigned r; asm volatile("v_cvt_pk_bf16_f32 %0, %1, %2" : "=v"(r) : "v"(lo), "v"(hi)); return r; }
typedef float f32x2 __attribute__((ext_vector_type(2)));

template <class Epi, class Sched, bool ALIGN_EPI = false, bool SP2 = false>
__device__ __forceinline__ void gemm_phase(PG8_LAS unsigned char* lds, const Gemm g, const Sched& S, const Epi& E) {
    int tid_ = threadIdx.x; asm volatile("" : "+v"(tid_)); const int tid = tid_, wid = __builtin_amdgcn_readfirstlane(tid >> 6), lane = tid & 63, wr = wid >> 2, wc = wid & 3, fr = lane & 15, fq = lane >> 4;
    const int K = g.K, nt = K / BK;
    unsigned voffA[2], voffB[2];
#pragma unroll
    for (int i = 0; i < 2; ++i) { int R, C; stage_rc(tid * 16 + i * 8192, R, C); const int Rb = Epi::PERM ? ((R & ~31) + perm32(R & 31)) : R;
        voffA[i] = (unsigned)(R * g.lda + C) * 2u; voffB[i] = (unsigned)(Rb * g.ldb + C) * 2u; }
    const size_t kstep = (size_t)(BK * 2);
    const size_t hstepA = (size_t)HALF * g.lda * 2, hstepB = (size_t)HALF * g.ldb * 2;
    const size_t tstepA = 2 * hstepA, tstepB = 2 * hstepB;
    const unsigned ldsw = (unsigned)wid * 1024u;
    const int aoff = lds_byte(wr * 64 + fr, fq * 8), boff = lds_byte(wc * 32 + fr, fq * 8);
#define PG8_SA(b, h) (((b) * 2 + (h)) * HTB)
#define PG8_SB(b, h) ((4 + (b) * 2 + (h)) * HTB)
#define PG8_STAGE(bufoff, gbase, voff) do { _Pragma("unroll") for (int _i = 0; _i < 2; ++_i) \
        __builtin_amdgcn_global_load_lds((const unsigned*)((const char*)(gbase) + (voff)[_i]), (PG8_LAS unsigned*)(lds + (bufoff) + ldsw + _i * 8192), 16, 0, 0); } while (0)
#define PG8_LDA(dst, b, h) do { _Pragma("unroll") for (int m = 0; m < 4; ++m) _Pragma("unroll") for (int k = 0; k < 2; ++k) dst[m][k] = *(const PG8_LAS bf16x8*)(lds + PG8_SA(b, h) + aoff + m * 2048 + k * 1024); } while (0)
#define PG8_LDB(dst, b, h) do { _Pragma("unroll") for (int n = 0; n < 2; ++n) _Pragma("unroll") for (int k = 0; k < 2; ++k) dst[n][k] = *(const PG8_LAS bf16x8*)(lds + PG8_SB(b, h) + boff + n * 2048 + k * 1024); } while (0)
#define PG8_MMA(ai, bj, At, Bt) do { __builtin_amdgcn_s_setprio(1); _Pragma("unroll") for (int m = 0; m < 4; ++m) _Pragma("unroll") for (int n = 0; n < 2; ++n) _Pragma("unroll") for (int k = 0; k < 2; ++k) \
        acc[ai][bj][m][n] = __builtin_amdgcn_mfma_f32_16x16x32_bf16(Bt[n][k], At[m][k], acc[ai][bj][m][n], 0, 0, 0); __builtin_amdgcn_s_setprio(0); } while (0)
#define PG8_WAIT_V(n) asm volatile("s_waitcnt vmcnt(" #n ")" ::: "memory")
#define PG8_WAIT_L(n) asm volatile("s_waitcnt lgkmcnt(" #n ")" ::: "memory")
#define PG8_BAR __builtin_amdgcn_s_barrier()
#define PG8_SCHED __builtin_amdgcn_sched_barrier(0)
    Unit cur, nxt; int ui = 0;
    if (!S.next(0, cur)) return;
    f32x4 acc[2][2][4][2];
#pragma unroll
    for (int a = 0; a < 2; ++a)
#pragma unroll
        for (int b = 0; b < 2; ++b)
#pragma unroll
            for (int m = 0; m < 4; ++m)
#pragma unroll
                for (int n = 0; n < 2; ++n) acc[a][b][m][n] = (f32x4){0.f, 0.f, 0.f, 0.f};
    bf16x8 At[4][2], B0[2][2], B1[2][2];
    const char* cA = (const char*)g.A + (size_t)cur.pm * tstepA; const char* cB = (const char*)g.Bt + (size_t)cur.pn * tstepB;
    S.a_ready(cur);
    if constexpr (SP2) {
        PG8_STAGE(PG8_SB(0, 0), cB, voffB); PG8_STAGE(PG8_SB(0, 1), cB + hstepB, voffB); PG8_STAGE(PG8_SA(0, 0), cA, voffA); PG8_STAGE(PG8_SA(0, 1), cA + hstepA, voffA);
        if (wr == 1) PG8_BAR;
        PG8_WAIT_V(2); PG8_BAR;
        PG8_STAGE(PG8_SB(1, 0), cB + kstep, voffB); PG8_STAGE(PG8_SA(1, 0), cA + kstep, voffA); PG8_STAGE(PG8_SB(1, 1), cB + hstepB + kstep, voffB);
        PG8_WAIT_V(6); PG8_BAR;
    } else {
        PG8_STAGE(PG8_SB(0, 0), cB, voffB); PG8_STAGE(PG8_SA(0, 0), cA, voffA); PG8_STAGE(PG8_SB(0, 1), cB + hstepB, voffB); PG8_STAGE(PG8_SA(0, 1), cA + hstepA, voffA);
        if (wr == 1) PG8_BAR;
        PG8_WAIT_V(4); PG8_BAR;
        PG8_STAGE(PG8_SB(1, 0), cB + kstep, voffB); PG8_STAGE(PG8_SA(1, 0), cA + kstep, voffA); PG8_STAGE(PG8_SB(1, 1), cB + hstepB + kstep, voffB);
        PG8_WAIT_V(6); PG8_BAR;
    }
    for (;;) {
        const bool has_next = S.next(ui + 1, nxt);
        const char* nA = has_next ? (const char*)g.A + (size_t)nxt.pm * tstepA : cA; const char* nB = has_next ? (const char*)g.Bt + (size_t)nxt.pn * tstepB : cB;
        for (int t = 0; t < nt; t += 2) {
            const bool last = (t == nt - 2);
            const char* a1 = cA + (size_t)(t + 1) * kstep;
            const char* a2 = last ? nA : cA + (size_t)(t + 2) * kstep; const char* b2 = last ? nB : cB + (size_t)(t + 2) * kstep;
            const char* a3 = a2 + kstep; const char* b3 = b2 + kstep;
            if (last && has_next) S.a_ready(nxt);
            if constexpr (SP2) {
            PG8_LDB(B0, 0, 0); PG8_LDB(B1, 0, 1); PG8_SCHED; PG8_LDA(At, 0, 0); PG8_STAGE(PG8_SA(1, 1), a1 + hstepA, voffA);
            PG8_WAIT_V(8); PG8_WAIT_L(0); PG8_BAR; PG8_MMA(0, 0, At, B0); PG8_MMA(0, 1, At, B1); PG8_BAR; PG8_SCHED;
            PG8_LDA(At, 0, 1); PG8_STAGE(PG8_SB(0, 0), b2, voffB); PG8_STAGE(PG8_SB(0, 1), b2 + hstepB, voffB); PG8_STAGE(PG8_SA(0, 0), a2, voffA);
            PG8_WAIT_V(8); PG8_WAIT_L(0); PG8_BAR; PG8_MMA(1, 0, At, B0); PG8_MMA(1, 1, At, B1); PG8_BAR; PG8_SCHED;
            PG8_LDB(B0, 1, 0); PG8_LDB(B1, 1, 1); PG8_SCHED; PG8_LDA(At, 1, 0); PG8_STAGE(PG8_SA(0, 1), a2 + hstepA, voffA);
            PG8_WAIT_V(8); PG8_WAIT_L(0); PG8_BAR; PG8_MMA(0, 0, At, B0); PG8_MMA(0, 1, At, B1); PG8_BAR; PG8_SCHED;
            PG8_LDA(At, 1, 1); PG8_STAGE(PG8_SB(1, 0), b3, voffB); PG8_STAGE(PG8_SB(1, 1), b3 + hstepB, voffB); PG8_STAGE(PG8_SA(1, 0), a3, voffA);
            PG8_WAIT_V(8); PG8_WAIT_L(0); PG8_BAR; PG8_MMA(1, 0, At, B0); PG8_MMA(1, 1, At, B1); PG8_BAR; PG8_SCHED;
            } else {
            PG8_LDB(B0, 0, 0); PG8_SCHED; PG8_LDA(At, 0, 0); PG8_STAGE(PG8_SA(1, 1), a1 + hstepA, voffA);
            PG8_WAIT_L(8); PG8_BAR; PG8_WAIT_L(0); PG8_MMA(0, 0, At, B0); PG8_BAR; PG8_SCHED;
            PG8_LDB(B1, 0, 1); PG8_STAGE(PG8_SB(0, 0), b2, voffB);
            PG8_BAR; PG8_WAIT_L(0); PG8_MMA(0, 1, At, B1); PG8_BAR;
            PG8_LDA(At, 0, 1); PG8_STAGE(PG8_SA(0, 0), a2, voffA);
            PG8_BAR; PG8_WAIT_L(0); PG8_MMA(1, 0, At, B0); PG8_BAR; PG8_SCHED;
            PG8_STAGE(PG8_SB(0, 1), b2 + hstepB, voffB);
            PG8_WAIT_V(6); PG8_BAR; PG8_MMA(1, 1, At, B1); PG8_BAR;
            PG8_LDB(B0, 1, 0); PG8_SCHED; PG8_LDA(At, 1, 0); PG8_STAGE(PG8_SA(0, 1), a2 + hstepA, voffA);
            PG8_WAIT_L(8); PG8_BAR; PG8_WAIT_L(0); PG8_MMA(0, 0, At, B0); PG8_BAR; PG8_SCHED;
            PG8_LDB(B1, 1, 1); PG8_STAGE(PG8_SB(1, 0), b3, voffB);
            PG8_BAR; PG8_WAIT_L(0); PG8_MMA(0, 1, At, B1); PG8_BAR;
            PG8_LDA(At, 1, 1); PG8_STAGE(PG8_SA(1, 0), a3, voffA);
            PG8_BAR; PG8_WAIT_L(0); PG8_MMA(1, 0, At, B0); PG8_BAR; PG8_SCHED;
            PG8_STAGE(PG8_SB(1, 1), b3 + hstepB, voffB);
            PG8_WAIT_V(6); PG8_BAR; PG8_MMA(1, 1, At, B1); PG8_BAR;
            }
        }
        if constexpr (ALIGN_EPI) { if (wr == 0) PG8_BAR; }
        if constexpr (!Epi::AFTER_DRAIN) { E(acc, cur, wr, wc, fr, fq); S.done(cur); }
        if (!has_next) break;
#pragma unroll
        for (int a = 0; a < 2; ++a)
#pragma unroll
            for (int b = 0; b < 2; ++b)
#pragma unroll
                for (int m = 0; m < 4; ++m)
#pragma unroll
                    for (int n = 0; n < 2; ++n) acc[a][b][m][n] = (f32x4){0.f, 0.f, 0.f, 0.f};
        cur = nxt; cA = nA; cB = nB; ++ui;
        if constexpr (ALIGN_EPI) { if (wr == 1) PG8_BAR; }
    }
    PG8_WAIT_V(0);
    if constexpr (!ALIGN_EPI) { if (wr == 0) PG8_BAR; }
    PG8_BAR;
    if constexpr (Epi::AFTER_DRAIN) { E.fused(acc, cur, wr, wc, fr, fq, lds, wid, lane); S.done(cur); }
#undef PG8_SA
#undef PG8_SB
#undef PG8_STAGE
#undef PG8_LDA
#undef PG8_LDB
#undef PG8_MMA
#undef PG8_WAIT_V
#undef PG8_WAIT_L
#undef PG8_BAR
#undef PG8_SCHED
}
}
#ifndef PHASES
#define PHASES 0xFFFF
#endif

#define LAS __attribute__((address_space(3)))
typedef unsigned short bf16;
typedef float f32x4 __attribute__((ext_vector_type(4)));
typedef short bf16x8 __attribute__((ext_vector_type(8)));
typedef unsigned u32x4 __attribute__((ext_vector_type(4)));
typedef unsigned u32x2 __attribute__((ext_vector_type(2)));

constexpr int NPROMPT = 8 * 2048, NSAMPLE = 128 * 8, MTOK = NPROMPT + NSAMPLE;
constexpr int DM = 1024, DFF = 2816, NADA = 9216, NSEQ = 136, INCOLS = 8704;
constexpr int NTHREADS = 512, NWAVES = 8;

constexpr size_t MiB = 1u << 20;
constexpr size_t WS_ADA = 0, WS_CSIL = 10 * MiB, WS_ROPE = 11 * MiB;
constexpr size_t WS_W13A = 12 * MiB, WS_W2A = 23 * MiB, WS_W13B = 29 * MiB, WS_W2B = 40 * MiB, WS_WIN = 46 * MiB;
constexpr size_t WS_WRET = 63 * MiB, WS_WCONF = 65 * MiB, WS_WSC = 66 * MiB, WS_WO = 67 * MiB;
constexpr size_t WS_H = 69 * MiB;
constexpr size_t WS_Z = 103 * MiB;
constexpr size_t WS_Q = WS_Z, WS_K = WS_Z + 17 * MiB, WS_V = WS_Z + 34 * MiB, WS_G = WS_Z + 68 * MiB;
constexpr size_t WS_CA = WS_Z + 102 * MiB, WS_CB = WS_Z + 119 * MiB, WS_SB = WS_Z + 136 * MiB, WS_SCC = WS_Z + 153 * MiB, WS_SX = WS_Z + 170 * MiB;
constexpr size_t WS_GL = WS_Z + 187 * MiB;
constexpr size_t WS_END = WS_GL + 102 * MiB;
constexpr size_t WS_U = WS_Z;
constexpr size_t WS_WADA = WS_Z;
constexpr size_t WS_M32 = WS_CA;
constexpr size_t WS_MBF = WS_V;

constexpr size_t O_Y = 0, O_RETP = 17825792, O_RETS = 18874368, O_CONFP = 35651584, O_CONFS = 35897344, O_SCP = 39829504, O_SCS = 39845888, O_END = 40108032;

constexpr int LDS_BYTES = 147456;

__device__ __forceinline__ unsigned f2bf(float f) { unsigned u = __builtin_bit_cast(unsigned, f); return (u + 0x7fffu + ((u >> 16) & 1u)) >> 16; }
__device__ __forceinline__ unsigned pk2(float lo, float hi) { return f2bf(lo) | (f2bf(hi) << 16); }
__device__ __forceinline__ float bf2f(unsigned b) { return __builtin_bit_cast(float, b << 16); }
__device__ __forceinline__ float bflo(unsigned w) { return __builtin_bit_cast(float, w << 16); }
__device__ __forceinline__ float bfhi(unsigned w) { return __builtin_bit_cast(float, w & 0xffff0000u); }
__device__ __forceinline__ float sigmoidf_(float x) { return __builtin_amdgcn_rcpf(1.0f + __expf(-x)); }
__device__ __forceinline__ float siluf_(float x) { return x * sigmoidf_(x); }
__device__ __forceinline__ int seq_of_row(int row) { return row < NPROMPT ? (row >> 11) : 8 + ((row - NPROMPT) >> 3); }
__device__ __forceinline__ float wave_sum(float v) {
#pragma unroll
    for (int o = 1; o < 64; o <<= 1) v += __shfl_xor(v, o);
    return v;
}
__device__ __forceinline__ float lgamma_h(int h) {
    float r = -0.0317486983145803f;
    r = h == 1 ? -0.015748356968139168f : r; r = h == 2 ? -0.007843177461025893f : r; r = h == 3 ? -0.003913899321136329f : r;
    r = h == 4 ? -0.0019550348358033506f : r; r = h == 5 ? -0.0009770396478266127f : r; r = h == 6 ? -0.0004884004981088745f : r; r = h == 7 ? -0.0002441704321739145f : r;
    return r;
}

using pg8::Unit;
struct EpiSwiglu {
    static constexpr bool PERM = true, AFTER_DRAIN = false;
    bf16* U;
    __device__ __forceinline__ void operator()(const f32x4 (&acc)[2][2][4][2], const Unit& u, int wr, int wc, int fr, int fq) const {
        const int row0 = u.pm * 256 + wr * 64 + fr, ucol0 = u.pn * 128 + wc * 16 + 4 * fq;
#pragma unroll
        for (int ai = 0; ai < 2; ++ai)
#pragma unroll
            for (int m = 0; m < 4; ++m) { bf16* rowp = U + (size_t)(row0 + ai * 128 + m * 16) * DFF + ucol0;
#pragma unroll
                for (int bj = 0; bj < 2; ++bj) { const f32x4 v0 = acc[ai][bj][m][0], v1 = acc[ai][bj][m][1];
                    u32x2 w; w.x = pk2(siluf_(v0[0]) * v1[0], siluf_(v0[1]) * v1[1]); w.y = pk2(siluf_(v0[2]) * v1[2], siluf_(v0[3]) * v1[3]);
                    *(u32x2*)(rowp + bj * 64) = w; } }
    }
};
struct EpiResid {
    static constexpr bool PERM = false, AFTER_DRAIN = false;
    float* x; const float* gate; float coef;
    __device__ __forceinline__ void operator()(const f32x4 (&acc)[2][2][4][2], const Unit& u, int wr, int wc, int fr, int fq) const {
        const int col0 = u.pn * 256 + wc * 32 + 4 * fq;
#pragma unroll
        for (int ai = 0; ai < 2; ++ai)
#pragma unroll
            for (int m = 0; m < 4; ++m) { const int row = u.pm * 256 + ai * 128 + wr * 64 + m * 16 + fr; const float* gp = gate + (size_t)seq_of_row(row) * NADA + col0; float* xp = x + (size_t)row * DM + col0;
#pragma unroll
                for (int bj = 0; bj < 2; ++bj)
#pragma unroll
                    for (int n = 0; n < 2; ++n) { const int c = bj * 128 + n * 16; const f32x4 g4 = *(const f32x4*)(gp + c); const f32x4 xv = *(const f32x4*)(xp + c);
                        *(f32x4*)(xp + c) = xv + acc[ai][bj][m][n] * g4 * coef; } }
    }
};
template <int MODE> struct EpiBranch {
    static constexpr bool PERM = false, AFTER_DRAIN = false;
    const bf16* GL; const float* bgate; float* M32; bf16* MBF; int br;
    __device__ __forceinline__ void operator()(const f32x4 (&acc)[2][2][4][2], const Unit& u, int wr, int wc, int fr, int fq) const {
        const int col0 = u.pn * 256 + wc * 32 + 4 * fq;
#pragma unroll
        for (int ai = 0; ai < 2; ++ai)
#pragma unroll
            for (int m = 0; m < 4; ++m) { const int row = u.pm * 256 + ai * 128 + wr * 64 + m * 16 + fr;
#pragma unroll
                for (int bj = 0; bj < 2; ++bj)
#pragma unroll
                    for (int n = 0; n < 2; ++n) { const int c = col0 + bj * 128 + n * 16;
                        const u32x2 gw = *(const u32x2*)(GL + (size_t)row * 3072 + br * 1024 + c); const f32x4 bg = *(const f32x4*)(bgate + br * 1024 + c);
                        f32x4 g; g[0] = sigmoidf_(bflo(gw.x) + bg[0]); g[1] = sigmoidf_(bfhi(gw.x) + bg[1]); g[2] = sigmoidf_(bflo(gw.y) + bg[2]); g[3] = sigmoidf_(bfhi(gw.y) + bg[3]);
                        f32x4 v = g * acc[ai][bj][m][n];
                        float* mp = M32 + (size_t)row * DM + c;
                        if (MODE == 0) { *(f32x4*)mp = v; }
                        else if (MODE == 1) { *(f32x4*)mp = *(const f32x4*)mp + v; }
                        else { v = v + *(const f32x4*)mp; u32x2 w; w.x = pk2(v[0], v[1]); w.y = pk2(v[2], v[3]); *(u32x2*)(MBF + (size_t)row * DM + c) = w; } } }
    }
};
struct EpiWin {
    static constexpr bool PERM = true, AFTER_DRAIN = false;
    unsigned char* ws;
    __device__ __forceinline__ void operator()(const f32x4 (&acc)[2][2][4][2], const Unit& u, int wr, int wc, int fr, int fq) const {
        const int colt = u.pn * 256; size_t off; int ld, c0;
        if (colt < 512) { off = WS_Q; ld = 512; c0 = colt; }
        else if (colt < 1024) { off = WS_K; ld = 512; c0 = colt - 512; }
        else if (colt < 2048) { off = WS_V; ld = 1024; c0 = colt - 1024; }
        else if (colt < 3072) { off = WS_G; ld = 1024; c0 = colt - 2048; }
        else if (colt < 3584) { off = WS_CA; ld = 512; c0 = colt - 3072; }
        else if (colt < 4096) { off = WS_CB; ld = 512; c0 = colt - 3584; }
        else if (colt < 4608) { off = WS_SB; ld = 512; c0 = colt - 4096; }
        else if (colt < 5120) { off = WS_SCC; ld = 512; c0 = colt - 4608; }
        else if (colt < 5632) { off = WS_SX; ld = 512; c0 = colt - 5120; }
        else { off = WS_GL; ld = 3072; c0 = colt - 5632; }
        bf16* base = (bf16*)(ws + off);
        const int row0 = u.pm * 256 + wr * 64 + fr, col0 = c0 + wc * 32 + 8 * fq;
#pragma unroll
        for (int ai = 0; ai < 2; ++ai)
#pragma unroll
            for (int m = 0; m < 4; ++m) { bf16* rowp = base + (size_t)(row0 + ai * 128 + m * 16) * ld + col0;
#pragma unroll
                for (int bj = 0; bj < 2; ++bj) { const f32x4 v0 = acc[ai][bj][m][0], v1 = acc[ai][bj][m][1];
                    u32x4 w; w.x = pk2(v0[0], v0[1]); w.y = pk2(v0[2], v0[3]); w.z = pk2(v1[0], v1[1]); w.w = pk2(v1[2], v1[3]);
                    *(u32x4*)(rowp + bj * 128) = w; } }
    }
};
struct EpiAda {
    static constexpr bool PERM = false, AFTER_DRAIN = false;
    float* ADA; const float* bada;
    __device__ __forceinline__ void operator()(const f32x4 (&acc)[2][2][4][2], const Unit& u, int wr, int wc, int fr, int fq) const {
        const int l = u.pn / 36, col0 = (u.pn - l * 36) * 256 + wc * 32 + 4 * fq;
#pragma unroll
        for (int ai = 0; ai < 2; ++ai)
#pragma unroll
            for (int m = 0; m < 4; ++m) { const int row = ai * 128 + wr * 64 + m * 16 + fr;
                if (row < NSEQ) {
#pragma unroll
                    for (int bj = 0; bj < 2; ++bj)
#pragma unroll
                        for (int n = 0; n < 2; ++n) { const int c = col0 + bj * 128 + n * 16;
                            *(f32x4*)(ADA + ((size_t)l * NSEQ + row) * NADA + c) = acc[ai][bj][m][n] + *(const f32x4*)(bada + (size_t)l * NADA + c); } } }
    }
};

__device__ __forceinline__ void transpose_item(const float* W, int N, bf16* WT, int ldk, int mode, int row_off, LAS float* scr, int item, int lane) {
    const int nblk = N / 32, kb = item / nblk, nb = item % nblk, k0 = 64 * kb, n0 = 32 * nb;
#pragma unroll 8
    for (int i = 0; i < 32; ++i) { const int kk = 2 * i + (lane >> 5); scr[kk * 33 + (lane & 31)] = W[(size_t)(k0 + kk) * N + n0 + (lane & 31)]; }
    asm volatile("s_waitcnt lgkmcnt(0)" ::: "memory");
    const int c = lane & 7;
#pragma unroll
    for (int j = 0; j < 4; ++j) { const int n = (lane >> 3) + 8 * j; const LAS float* s = scr + (8 * c) * 33 + n; const int ng = n0 + n;
        const int row = mode == 0 ? row_off + ng : (((ng >> 2) << 3) + (mode == 2 ? 4 : 0) + (ng & 3));
        u32x4 o; o.x = pk2(s[0 * 33], s[1 * 33]); o.y = pk2(s[2 * 33], s[3 * 33]); o.z = pk2(s[4 * 33], s[5 * 33]); o.w = pk2(s[6 * 33], s[7 * 33]);
        *(u32x4*)(WT + (size_t)row * ldk + k0 + 8 * c) = o; }
    asm volatile("s_waitcnt lgkmcnt(0)" ::: "memory");
}

struct Args { const float* in[31]; float* out; unsigned char* ws; };
typedef const __attribute__((address_space(4))) Args* ArgsP;

#define CONV(Wp, Kk, Nn, WTp, ldk, mode, roff) { const int cnt_ = ((Kk) / 64) * ((Nn) / 32); if (r < cnt_) { transpose_item((Wp), (Nn), (WTp), (ldk), (mode), (roff), scr, r, lane); continue; } r -= cnt_; }
constexpr int LAYER_CONV_ITEMS = 6 * 1408 + 4352 + 512 + 256 + 256 + 512;
__device__ __forceinline__ void convert_layer_weights(ArgsP ap, unsigned char* ws, int l, LAS unsigned char* lds, int gw, int NGW, int wave, int lane) {
    LAS float* scr = (LAS float*)(lds + wave * 16384);
    const size_t ffo = (size_t)l * DM * DFF;
    for (int it = gw; it < LAYER_CONV_ITEMS; it += NGW) {
        int r = it;
        CONV(ap->in[10] + ffo, 1024, 2816, (bf16*)(ws + WS_W13A), 1024, 1, 0)
        CONV(ap->in[11] + ffo, 1024, 2816, (bf16*)(ws + WS_W13A), 1024, 2, 0)
        CONV(ap->in[12] + ffo, 2816, 1024, (bf16*)(ws + WS_W2A), 2816, 0, 0)
        CONV(ap->in[27] + ffo, 1024, 2816, (bf16*)(ws + WS_W13B), 1024, 1, 0)
        CONV(ap->in[28] + ffo, 1024, 2816, (bf16*)(ws + WS_W13B), 1024, 2, 0)
        CONV(ap->in[29] + ffo, 2816, 1024, (bf16*)(ws + WS_W2B), 2816, 0, 0)
        CONV(ap->in[14] + (size_t)l * DM * INCOLS, 1024, 8704, (bf16*)(ws + WS_WIN), 1024, 0, 0)
        CONV(ap->in[17] + (size_t)l * 1024 * 1024, 1024, 1024, (bf16*)(ws + WS_WRET), 1024, 0, 0)
        CONV(ap->in[22] + (size_t)l * 512 * 1024, 512, 1024, (bf16*)(ws + WS_WCONF), 512, 0, 0)
        CONV(ap->in[24] + (size_t)l * 512 * 1024, 512, 1024, (bf16*)(ws + WS_WSC), 512, 0, 0)
        transpose_item(ap->in[25] + (size_t)l * 1024 * 1024, 1024, (bf16*)(ws + WS_WO), 1024, 0, 0, scr, r, lane);
    }
}
__device__ __forceinline__ void convert_ada_weights(ArgsP ap, unsigned char* ws, LAS unsigned char* lds, int gw, int NGW, int wave, int lane) {
    LAS float* scr = (LAS float*)(lds + wave * 16384);
    for (int it = gw; it < 2 * 4608; it += NGW) { const int l = it / 4608, r = it - l * 4608;
        transpose_item(ap->in[7] + (size_t)l * DM * NADA, NADA, (bf16*)(ws + WS_WADA), 1024, 0, l * NADA, scr, r, lane); }
}

__device__ __forceinline__ void rmsmod_phase(const float* xp, const float* xs, float* xcopy, const float* gnorm, const float* ada_l, int sidx, bf16* H, int gw, int NGW, int lane) {
    for (int m = gw; m < MTOK; m += NGW) {
        const float* xrow = m < NPROMPT ? xp + (size_t)m * DM : xs + (size_t)(m - NPROMPT) * DM;
        const f32x4* xr = (const f32x4*)xrow + lane;
        f32x4 v[4]; float s = 0.f;
#pragma unroll
        for (int j = 0; j < 4; ++j) { v[j] = xr[64 * j]; s += (v[j][0] * v[j][0] + v[j][1] * v[j][1]) + (v[j][2] * v[j][2] + v[j][3] * v[j][3]); }
        const float rstd = 1.0f / sqrtf(wave_sum(s) * (1.f / DM) + 1e-6f);
        const float* sh = ada_l + (size_t)seq_of_row(m) * NADA + sidx * 1024; const float* sc = sh + 1024;
        if (xcopy) { f32x4* xc = (f32x4*)(xcopy + (size_t)m * DM) + lane;
#pragma unroll
            for (int j = 0; j < 4; ++j) xc[64 * j] = v[j]; }
        u32x2* o8 = (u32x2*)(H + (size_t)m * DM) + lane;
#pragma unroll
        for (int j = 0; j < 4; ++j) { const int c = 4 * (lane + 64 * j);
            const f32x4 g4 = *(const f32x4*)(gnorm + c), s4 = *(const f32x4*)(sh + c), c4 = *(const f32x4*)(sc + c);
            const f32x4 o = v[j] * rstd * g4 * (c4 + 1.0f) + s4;
            u32x2 w; w.x = pk2(o[0], o[1]); w.y = pk2(o[2], o[3]); o8[64 * j] = w; }
    }
}
__device__ __forceinline__ void final_norm_phase(float* x, const float* g, int gw, int NGW, int lane) {
    for (int m = gw; m < MTOK; m += NGW) {
        f32x4* xr = (f32x4*)(x + (size_t)m * DM) + lane;
        f32x4 v[4]; float s = 0.f;
#pragma unroll
        for (int j = 0; j < 4; ++j) { v[j] = xr[64 * j]; s += (v[j][0] * v[j][0] + v[j][1] * v[j][1]) + (v[j][2] * v[j][2] + v[j][3] * v[j][3]); }
        const float rstd = 1.0f / sqrtf(wave_sum(s) * (1.f / DM) + 1e-6f);
#pragma unroll
        for (int j = 0; j < 4; ++j) { const f32x4 g4 = *(const f32x4*)(g + 4 * (lane + 64 * j)); xr[64 * j] = v[j] * rstd * g4; }
    }
}

#define MFMA16(a, b, c) __builtin_amdgcn_mfma_f32_16x16x32_bf16((a), (b), (c), 0, 0, 0)
constexpr int RS64 = 72, RS128 = 136;
constexpr int L_QS = 0, L_KS = 18432, L_KT = 36864, L_VT = 54272, L_PS = 89088, L_ST = 123904;

__device__ __forceinline__ void ret_prompt_unit(LAS unsigned char* lds, const bf16* Q, const bf16* K, const bf16* V, bf16* G, const float* rope, const float* gn_g, float* Sout, int b, int h, int tid) {
    LAS bf16* Qs = (LAS bf16*)(lds + L_QS); LAS bf16* Ks = (LAS bf16*)(lds + L_KS); LAS bf16* KTs = (LAS bf16*)(lds + L_KT);
    LAS bf16* VTs = (LAS bf16*)(lds + L_VT); LAS bf16* Ps = (LAS bf16*)(lds + L_PS); LAS bf16* STs = (LAS bf16*)(lds + L_ST);
    const int w = __builtin_amdgcn_readfirstlane(tid >> 6), lane = tid & 63, l15 = lane & 15, q4 = lane >> 4;
    const float lg = lgamma_h(h);
    for (int i = tid; i < 128 * RS64 / 2; i += NTHREADS) ((LAS unsigned*)STs)[i] = 0u;
    f32x4 S[4];
#pragma unroll
    for (int x = 0; x < 4; ++x) S[x] = (f32x4){0.f, 0.f, 0.f, 0.f};
    const float gam = __expf(lg), cd = __expf(128.f * lg), g127 = __expf(127.f * lg);
    const int dt = w & 3, et0 = (w >> 2) * 4;
    for (int c = 0; c < 16; ++c) {
        const int row0 = b * 2048 + c * 128;
        {
            const int i = tid >> 2, gq = tid & 3; const size_t rb = (size_t)(row0 + i) * 512 + h * 64 + 8 * gq;
            const u32x4 qlo = *(const u32x4*)(Q + rb), qhi = *(const u32x4*)(Q + rb + 32), klo = *(const u32x4*)(K + rb), khi = *(const u32x4*)(K + rb + 32);
            const f32x4* rp = (const f32x4*)(rope + ((size_t)(c * 128 + i) * 32 + 8 * gq) * 2);
            const f32x4 r0 = rp[0], r1 = rp[1], r2 = rp[2], r3 = rp[3];
            const float cs[8] = {r0[0], r0[2], r1[0], r1[2], r2[0], r2[2], r3[0], r3[2]}, sn[8] = {r0[1], r0[3], r1[1], r1[3], r2[1], r2[3], r3[1], r3[3]};
            const unsigned ql[4] = {qlo.x, qlo.y, qlo.z, qlo.w}, qh[4] = {qhi.x, qhi.y, qhi.z, qhi.w}, kl[4] = {klo.x, klo.y, klo.z, klo.w}, kh[4] = {khi.x, khi.y, khi.z, khi.w};
            const float gi = __expf((float)i * lg) * 0.125f, gk = __expf(-(float)i * lg);
            float qa[8], qb[8], ka[8], kb[8];
#pragma unroll
            for (int x = 0; x < 8; ++x) {
                const float q1 = (x & 1) ? bfhi(ql[x >> 1]) : bflo(ql[x >> 1]), q2 = (x & 1) ? bfhi(qh[x >> 1]) : bflo(qh[x >> 1]);
                const float k1 = (x & 1) ? bfhi(kl[x >> 1]) : bflo(kl[x >> 1]), k2 = (x & 1) ? bfhi(kh[x >> 1]) : bflo(kh[x >> 1]);
                qa[x] = (q1 * cs[x] - q2 * sn[x]) * gi; qb[x] = (q1 * sn[x] + q2 * cs[x]) * gi;
                ka[x] = (k1 * cs[x] - k2 * sn[x]) * gk; kb[x] = (k1 * sn[x] + k2 * cs[x]) * gk;
            }
            u32x4 t;
            t.x = pk2(qa[0], qa[1]); t.y = pk2(qa[2], qa[3]); t.z = pk2(qa[4], qa[5]); t.w = pk2(qa[6], qa[7]); *(LAS u32x4*)(Qs + i * RS64 + 8 * gq) = t;
            t.x = pk2(qb[0], qb[1]); t.y = pk2(qb[2], qb[3]); t.z = pk2(qb[4], qb[5]); t.w = pk2(qb[6], qb[7]); *(LAS u32x4*)(Qs + i * RS64 + 32 + 8 * gq) = t;
            t.x = pk2(ka[0], ka[1]); t.y = pk2(ka[2], ka[3]); t.z = pk2(ka[4], ka[5]); t.w = pk2(ka[6], ka[7]); *(LAS u32x4*)(Ks + i * RS64 + 8 * gq) = t;
            t.x = pk2(kb[0], kb[1]); t.y = pk2(kb[2], kb[3]); t.z = pk2(kb[4], kb[5]); t.w = pk2(kb[6], kb[7]); *(LAS u32x4*)(Ks + i * RS64 + 32 + 8 * gq) = t;
#pragma unroll
            for (int x = 0; x < 8; ++x) { KTs[(8 * gq + x) * RS128 + i] = (bf16)f2bf(ka[x]); KTs[(32 + 8 * gq + x) * RS128 + i] = (bf16)f2bf(kb[x]); }
        }
        {
            const int j = tid >> 2;
#pragma unroll
            for (int y = 0; y < 4; ++y) { const int e0 = 32 * (tid & 3) + 8 * y; const u32x4 vv = *(const u32x4*)(V + (size_t)(row0 + j) * 1024 + h * 128 + e0);
                const unsigned vw[4] = {vv.x, vv.y, vv.z, vv.w};
#pragma unroll
                for (int x = 0; x < 8; ++x) VTs[(e0 + x) * RS128 + j] = (bf16)((x & 1) ? (vw[x >> 1] >> 16) : (vw[x >> 1] & 0xffffu)); }
        }
        __syncthreads();
        const bf16x8 aq0 = *(const LAS bf16x8*)(Qs + (16 * w + l15) * RS64 + 8 * q4), aq1 = *(const LAS bf16x8*)(Qs + (16 * w + l15) * RS64 + 32 + 8 * q4);
        const int jt_hi = w | 1;
        for (int jt = 0; jt <= jt_hi; ++jt) {
            const bf16x8 b0 = *(const LAS bf16x8*)(Ks + (16 * jt + l15) * RS64 + 8 * q4), b1 = *(const LAS bf16x8*)(Ks + (16 * jt + l15) * RS64 + 32 + 8 * q4);
            f32x4 s = (f32x4){0.f, 0.f, 0.f, 0.f}; s = MFMA16(aq0, b0, s); s = MFMA16(aq1, b1, s);
            const int j = 16 * jt + l15;
#pragma unroll
            for (int r = 0; r < 4; ++r) { const int i = 16 * w + 4 * q4 + r; Ps[i * RS128 + j] = (bf16)f2bf(j <= i ? s[r] : 0.f); }
        }
        f32x4 o[8];
#pragma unroll
        for (int et = 0; et < 8; ++et) o[et] = (f32x4){0.f, 0.f, 0.f, 0.f};
        for (int ks = 0; ks <= (w >> 1); ++ks) {
            const bf16x8 a = *(const LAS bf16x8*)(Ps + (16 * w + l15) * RS128 + 32 * ks + 8 * q4);
#pragma unroll
            for (int et = 0; et < 8; ++et) { const bf16x8 bb = *(const LAS bf16x8*)(VTs + (16 * et + l15) * RS128 + 32 * ks + 8 * q4); o[et] = MFMA16(a, bb, o[et]); }
        }
#pragma unroll
        for (int ks = 0; ks < 2; ++ks) { const bf16x8 a = ks ? aq1 : aq0;
#pragma unroll
            for (int et = 0; et < 8; ++et) { const bf16x8 bb = *(const LAS bf16x8*)(STs + (16 * et + l15) * RS64 + 32 * ks + 8 * q4); o[et] = MFMA16(a, bb, o[et]); } }
#pragma unroll
        for (int r = 0; r < 4; ++r) {
            float s = 0.f;
#pragma unroll
            for (int et = 0; et < 8; ++et) s += o[et][r];
            s += __shfl_xor(s, 1); s += __shfl_xor(s, 2); s += __shfl_xor(s, 4); s += __shfl_xor(s, 8);
            const float mean = s * (1.f / 128.f); float vs = 0.f;
#pragma unroll
            for (int et = 0; et < 8; ++et) { const float d = o[et][r] - mean; vs += d * d; }
            vs += __shfl_xor(vs, 1); vs += __shfl_xor(vs, 2); vs += __shfl_xor(vs, 4); vs += __shfl_xor(vs, 8);
            const float rstd = 1.0f / sqrtf(vs * (1.f / 128.f) + 1e-5f);
            bf16* gp = G + (size_t)(row0 + 16 * w + 4 * q4 + r) * 1024 + h * 128 + l15;
#pragma unroll
            for (int et = 0; et < 8; ++et) { const float y = (o[et][r] - mean) * rstd * gn_g[h * 128 + 16 * et + l15]; const float gv = bf2f(gp[16 * et]); gp[16 * et] = (bf16)f2bf(siluf_(gv) * y); }
        }
        f32x4 kv[4];
#pragma unroll
        for (int x = 0; x < 4; ++x) kv[x] = (f32x4){0.f, 0.f, 0.f, 0.f};
#pragma unroll
        for (int ks = 0; ks < 4; ++ks) { const bf16x8 a = *(const LAS bf16x8*)(KTs + (16 * dt + l15) * RS128 + 32 * ks + 8 * q4);
#pragma unroll
            for (int x = 0; x < 4; ++x) { const bf16x8 bb = *(const LAS bf16x8*)(VTs + (16 * (et0 + x) + l15) * RS128 + 32 * ks + 8 * q4); kv[x] = MFMA16(a, bb, kv[x]); } }
#pragma unroll
        for (int x = 0; x < 4; ++x) S[x] = S[x] * cd + kv[x] * g127;
        __syncthreads();
#pragma unroll
        for (int x = 0; x < 4; ++x) { u32x2 t; t.x = pk2(gam * S[x][0], gam * S[x][1]); t.y = pk2(gam * S[x][2], gam * S[x][3]);
            *(LAS u32x2*)(STs + (16 * (et0 + x) + l15) * RS64 + 16 * dt + 4 * q4) = t; }
    }
#pragma unroll
    for (int x = 0; x < 4; ++x)
#pragma unroll
        for (int r = 0; r < 4; ++r) Sout[(16 * dt + 4 * q4 + r) * 128 + 16 * (et0 + x) + l15] = S[x][r];
    __syncthreads();
}

__device__ __forceinline__ void ret_sample_unit(LAS unsigned char* lds, const bf16* Q, const bf16* K, const bf16* V, bf16* G, const float* rope, const float* gn_g, const float* S0, float* Sout, int bs, int h, int tid) {
    LAS float* qf = (LAS float*)lds; LAS float* kf = qf + 512; LAS float* vf = kf + 512; LAS float* sc = vf + 1024; LAS float* oc = sc + 64; LAS float* ob = oc + 4096;
    const int w = tid >> 6, lane = tid & 63; const float lg = lgamma_h(h); const int row0 = NPROMPT + bs * 8;
    {   const int which = tid >> 8, t2 = tid & 255, i = t2 >> 5, d = t2 & 31; const bf16* src = which ? K : Q; const size_t rb = (size_t)(row0 + i) * 512 + h * 64 + d;
        const float x1 = bf2f(src[rb]), x2 = bf2f(src[rb + 32]); const float cs = rope[((size_t)(2048 + i) * 32 + d) * 2], sn = rope[((size_t)(2048 + i) * 32 + d) * 2 + 1];
        const float scale = which ? 1.0f : 0.125f; LAS float* dst = which ? kf : qf;
        dst[i * 64 + d] = (x1 * cs - x2 * sn) * scale; dst[i * 64 + 32 + d] = (x1 * sn + x2 * cs) * scale; }
#pragma unroll
    for (int y = 0; y < 2; ++y) { const int idx = tid + 512 * y, j = idx >> 7, e = idx & 127; vf[idx] = bf2f(V[(size_t)(row0 + j) * 1024 + h * 128 + e]); }
    __syncthreads();
    if (tid < 64) { const int i = tid >> 3, j = tid & 7; float s = 0.f;
        if (j <= i) { for (int d = 0; d < 64; ++d) s += qf[i * 64 + d] * kf[j * 64 + d]; s *= __expf((float)(i - j) * lg); }
        sc[tid] = s; }
    const int e = tid & 127, dg = tid >> 7;
    float Sreg[16];
#pragma unroll
    for (int dd = 0; dd < 16; ++dd) Sreg[dd] = S0[(dg * 16 + dd) * 128 + e];
#pragma unroll
    for (int i = 0; i < 8; ++i) { float p = 0.f;
#pragma unroll
        for (int dd = 0; dd < 16; ++dd) p += qf[i * 64 + dg * 16 + dd] * Sreg[dd];
        oc[(dg * 8 + i) * 128 + e] = p; }
    const float g8 = __expf(8.f * lg);
    float vdec[8];
#pragma unroll
    for (int j = 0; j < 8; ++j) vdec[j] = __expf((float)(7 - j) * lg) * vf[j * 128 + e];
#pragma unroll
    for (int dd = 0; dd < 16; ++dd) { float acc = Sreg[dd] * g8;
#pragma unroll
        for (int j = 0; j < 8; ++j) acc += kf[j * 64 + dg * 16 + dd] * vdec[j];
        Sout[(dg * 16 + dd) * 128 + e] = acc; }
    __syncthreads();
#pragma unroll
    for (int y = 0; y < 2; ++y) { const int idx = tid + 512 * y, i = idx >> 7, ee = idx & 127;
        float o = (oc[(0 + i) * 128 + ee] + oc[(8 + i) * 128 + ee] + oc[(16 + i) * 128 + ee] + oc[(24 + i) * 128 + ee]) * __expf((float)(i + 1) * lg);
        for (int j = 0; j <= i; ++j) o += sc[i * 8 + j] * vf[j * 128 + ee];
        ob[idx] = o; }
    __syncthreads();
    {   const int i = w; const float v0 = ob[i * 128 + lane], v1 = ob[i * 128 + 64 + lane];
        const float mean = wave_sum(v0 + v1) * (1.f / 128.f); const float d0 = v0 - mean, d1 = v1 - mean;
        const float rstd = 1.0f / sqrtf(wave_sum(d0 * d0 + d1 * d1) * (1.f / 128.f) + 1e-5f);
        bf16* gp = G + (size_t)(row0 + i) * 1024 + h * 128 + lane;
        const float g0 = bf2f(gp[0]), g1 = bf2f(gp[64]);
        gp[0] = (bf16)f2bf(siluf_(g0) * d0 * rstd * gn_g[h * 128 + lane]); gp[64] = (bf16)f2bf(siluf_(g1) * d1 * rstd * gn_g[h * 128 + 64 + lane]); }
    __syncthreads();
}

template <int NT> __device__ __forceinline__ void conf_unit(LAS unsigned char* lds, const bf16* CA, const bf16* CB, bf16* XCS, const float* cw, const float* cbias, const float* lng, const float* lnb,
                                                             const float* state, float* state_out, int seqrow0, int t0, int T, int tid) {
    LAS float* U = (LAS float*)lds; LAS float* CV = U + 46 * 512;
    const int c = tid, w = tid >> 6, lane = tid & 63;
    float wreg[31];
#pragma unroll
    for (int k = 0; k < 31; ++k) wreg[k] = cw[k * 512 + c];
    const float bias = cbias[c];
    for (int it = tid; it < (30 + NT) * 64; it += NTHREADS) {
        const int r = it >> 6, c0 = (it & 63) * 8; f32x4 u0 = (f32x4){0.f, 0.f, 0.f, 0.f}, u1 = u0;
        if (state && r < 30) { u0 = *(const f32x4*)(state + r * 512 + c0); u1 = *(const f32x4*)(state + r * 512 + c0 + 4); }
        else { const int t = t0 - 30 + r;
            if (t >= 0) { const size_t gi = (size_t)(seqrow0 + t) * 512 + c0; const u32x4 av = *(const u32x4*)(CA + gi), bv = *(const u32x4*)(CB + gi);
                u0[0] = bflo(av.x) * sigmoidf_(bflo(bv.x)); u0[1] = bfhi(av.x) * sigmoidf_(bfhi(bv.x)); u0[2] = bflo(av.y) * sigmoidf_(bflo(bv.y)); u0[3] = bfhi(av.y) * sigmoidf_(bfhi(bv.y));
                u1[0] = bflo(av.z) * sigmoidf_(bflo(bv.z)); u1[1] = bfhi(av.z) * sigmoidf_(bfhi(bv.z)); u1[2] = bflo(av.w) * sigmoidf_(bflo(bv.w)); u1[3] = bfhi(av.w) * sigmoidf_(bfhi(bv.w));
                if (!state && r >= 30 && t >= T - 30) { float* so = state_out + (size_t)(t - (T - 30)) * 512 + c0; *(f32x4*)so = u0; *(f32x4*)(so + 4) = u1; } } }
        *(LAS f32x4*)(U + r * 512 + c0) = u0; *(LAS f32x4*)(U + r * 512 + c0 + 4) = u1;
    }
    __syncthreads();
    if (state) { for (int it = tid; it < 30 * 128; it += NTHREADS) { const int rr = it >> 7, c4 = (it & 127) * 4; *(f32x4*)(state_out + rr * 512 + c4) = *(const LAS f32x4*)(U + (rr + NT) * 512 + c4); } }
    float cv[NT];
#pragma unroll
    for (int tt = 0; tt < NT; ++tt) cv[tt] = bias;
#pragma unroll
    for (int r = 0; r < 30 + NT; ++r) { const float u = U[r * 512 + c];
#pragma unroll
        for (int tt = 0; tt < NT; ++tt) { if (r - tt >= 0 && r - tt <= 30) cv[tt] += wreg[r - tt] * u; } }
#pragma unroll
    for (int tt = 0; tt < NT; ++tt) CV[tt * 512 + c] = cv[tt];
    __syncthreads();
    for (int tt = w; tt < NT; tt += 8) {
        const f32x4 x0 = *(const LAS f32x4*)(CV + tt * 512 + lane * 8), x1 = *(const LAS f32x4*)(CV + tt * 512 + lane * 8 + 4);
        const float mean = wave_sum((x0[0] + x0[1]) + (x0[2] + x0[3]) + (x1[0] + x1[1]) + (x1[2] + x1[3])) * (1.f / 512.f);
        const f32x4 d0 = x0 - mean, d1 = x1 - mean;
        const float var = wave_sum((d0[0] * d0[0] + d0[1] * d0[1]) + (d0[2] * d0[2] + d0[3] * d0[3]) + (d1[0] * d1[0] + d1[1] * d1[1]) + (d1[2] * d1[2] + d1[3] * d1[3])) * (1.f / 512.f);
        const float rstd = 1.0f / sqrtf(var + 1e-5f);
        const f32x4 g0 = *(const f32x4*)(lng + lane * 8), g1 = *(const f32x4*)(lng + lane * 8 + 4), b0 = *(const f32x4*)(lnb + lane * 8), b1 = *(const f32x4*)(lnb + lane * 8 + 4);
        const f32x4 y0 = d0 * rstd * g0 + b0, y1 = d1 * rstd * g1 + b1;
        u32x4 o; o.x = pk2(siluf_(y0[0]), siluf_(y0[1])); o.y = pk2(siluf_(y0[2]), siluf_(y0[3])); o.z = pk2(siluf_(y1[0]), siluf_(y1[1])); o.w = pk2(siluf_(y1[2]), siluf_(y1[3]));
        *(u32x4*)(XCS + (size_t)(seqrow0 + t0 + tt) * 1024 + lane * 8) = o;
    }
    __syncthreads();
}

__device__ __forceinline__ void sconv_unit(const bf16* SB, const bf16* SCC, const bf16* SX, bf16* XCS, const float* scw, const float* state_l  , float* outp_l  , float* outs_l  , int tile, int tid) {
#pragma unroll 1
    for (int y = 0; y < 8; ++y) {
        const int item = tid + 512 * y, R = tile * 64 + (item >> 6), c0 = (item & 63) * 8;
        const bool prompt = R < NPROMPT; const int t = prompt ? (R & 2047) : ((R - NPROMPT) & 7); const int sq = prompt ? (R >> 11) : ((R - NPROMPT) >> 3);
        float us[3][8];
#pragma unroll
        for (int k = 0; k < 3; ++k) { const int tp = t - 2 + k;
            if (tp >= 0) { const size_t gi = (size_t)(R - 2 + k) * 512 + c0; const u32x4 a = *(const u32x4*)(SCC + gi), bq = *(const u32x4*)(SX + gi);
                const unsigned aw[4] = {a.x, a.y, a.z, a.w}, bw[4] = {bq.x, bq.y, bq.z, bq.w};
#pragma unroll
                for (int x = 0; x < 4; ++x) { us[k][2 * x] = bflo(aw[x]) * bflo(bw[x]); us[k][2 * x + 1] = bfhi(aw[x]) * bfhi(bw[x]); } }
            else if (prompt) {
#pragma unroll
                for (int x = 0; x < 8; ++x) us[k][x] = 0.f; }
            else { const float* sp = state_l + ((size_t)sq * 2 + (2 + tp)) * 512 + c0; const f32x4 s0 = *(const f32x4*)sp, s1 = *(const f32x4*)(sp + 4);
#pragma unroll
                for (int x = 0; x < 4; ++x) { us[k][x] = s0[x]; us[k][4 + x] = s1[x]; } } }
        const u32x4 sbv = *(const u32x4*)(SB + (size_t)R * 512 + c0); const unsigned sw[4] = {sbv.x, sbv.y, sbv.z, sbv.w};
        float o[8];
#pragma unroll
        for (int x = 0; x < 8; ++x) { const float sv = scw[c0 + x] * us[0][x] + scw[512 + c0 + x] * us[1][x] + scw[1024 + c0 + x] * us[2][x];
            o[x] = ((x & 1) ? bfhi(sw[x >> 1]) : bflo(sw[x >> 1])) * sv; }
        u32x4 ow; ow.x = pk2(o[0], o[1]); ow.y = pk2(o[2], o[3]); ow.z = pk2(o[4], o[5]); ow.w = pk2(o[6], o[7]);
        *(u32x4*)(XCS + (size_t)R * 1024 + 512 + c0) = ow;
        const int tl = prompt ? 2046 : 6;
        if (t >= tl) { float* op = (prompt ? outp_l : outs_l) + ((size_t)sq * 2 + (t - tl)) * 512 + c0;
            *(f32x4*)op = (f32x4){us[2][0], us[2][1], us[2][2], us[2][3]}; *(f32x4*)(op + 4) = (f32x4){us[2][4], us[2][5], us[2][6], us[2][7]}; }
    }
}

__global__ void __launch_bounds__(NTHREADS, 2) mega_fwd(Args a) {
    extern __shared__ __attribute__((aligned(16))) unsigned char lds_raw[];
    cg::grid_group grid = cg::this_grid();
    LAS unsigned char* lds = (LAS unsigned char*)lds_raw;
    const int G = gridDim.x, bid0 = blockIdx.x, NGW = G * NWAVES;
#define PHASE_BEGIN ArgsP ap = (ArgsP)__builtin_amdgcn_kernarg_segment_ptr(); asm volatile("" : "+s"(ap)); unsigned char* ws = ap->ws; float* XW = ap->out; int tid = threadIdx.x; asm volatile("" : "+v"(tid)); int bid = bid0; asm volatile("" : "+s"(bid)); \
    const int lane = tid & 63, wave = __builtin_amdgcn_readfirstlane(tid >> 6), gw = bid * NWAVES + wave; \
    float* ADA = (float*)(ws + WS_ADA); float* ROPE = (float*)(ws + WS_ROPE); bf16* H = (bf16*)(ws + WS_H); bf16* U = (bf16*)(ws + WS_U); \
    (void)lane; (void)wave; (void)gw; (void)ADA; (void)ROPE; (void)H; (void)U; (void)XW;
#define GEMM_PHASE(EPI, Aptr, Bptr, Mm, Nn, Kk, lda_, ldb_, ...) { pg8::Gemm g{(const bf16*)(Aptr), (const bf16*)(Bptr), (Mm), (Nn), (Kk), (lda_), (ldb_)}; pg8::StaticOrder S; S.init((Mm), (Nn), G, bid); \
        EPI E{__VA_ARGS__}; pg8::gemm_phase<EPI, pg8::StaticOrder, true, true>(lds, g, S, E); }

    {   PHASE_BEGIN
#if PHASES & 1
        convert_ada_weights(ap, ws, lds, gw, NGW, wave, lane);
#endif
        bf16* CS = (bf16*)(ws + WS_CSIL);
        for (int i = bid * NTHREADS + tid; i < 256 * 1024; i += G * NTHREADS) { const int r = i >> 10, c = i & 1023; float v = 0.f;
            if (r < 8) v = siluf_(ap->in[2][r * 1024 + c]); else if (r < NSEQ) v = siluf_(ap->in[3][(r - 8) * 1024 + c]);
            CS[i] = (bf16)f2bf(v); }
        for (int i = bid * NTHREADS + tid; i < 2056 * 32; i += G * NTHREADS) { const int p = i >> 5, k = i & 31; const int pos = p < 2048 ? p : 16384 + (p - 2048);
            double f = 0.15915494309189535; for (int q = 0; q < k; ++q) f *= 0.7498942093324559;
            double rv = (double)pos * f; rv -= __builtin_floor(rv); const float fr = (float)rv;
            ROPE[2 * i] = __builtin_amdgcn_cosf(fr); ROPE[2 * i + 1] = __builtin_amdgcn_sinf(fr); }
#if PHASES & 1
        convert_layer_weights(ap, ws, 0, lds, gw, NGW, wave, lane);
#endif
    }
    grid.sync();
    {   PHASE_BEGIN
#if PHASES & 1024
        GEMM_PHASE(EpiAda, ws + WS_CSIL, ws + WS_WADA, 256, 2 * NADA, 1024, 1024, 1024, ADA, ap->in[8])
#endif
    }
    grid.sync();

#pragma unroll 1
    for (int l = 0; l < 2; ++l) {
        {   PHASE_BEGIN
            const float* ada_l = ADA + (size_t)l * NSEQ * NADA;
            if (l == 0) rmsmod_phase(ap->in[0], ap->in[1], XW, ap->in[9], ada_l, 0, H, gw, NGW, lane);
            else { rmsmod_phase(XW, XW + (size_t)NPROMPT * DM, nullptr, ap->in[9] + l * DM, ada_l, 0, H, gw, NGW, lane);
#if PHASES & 1
                convert_layer_weights(ap, ws, l, lds, gw, NGW, wave, lane);
#endif
            } }
        grid.sync();
        {   PHASE_BEGIN
#if PHASES & 2
            GEMM_PHASE(EpiSwiglu, H, ws + WS_W13A, MTOK, 2 * DFF, 1024, 1024, 1024, U)
#ifdef PROBE_UP
            GEMM_PHASE(EpiSwiglu, H, ws + WS_W13A, MTOK, 2 * DFF, 1024, 1024, 1024, U)
#endif
#endif
        }
        grid.sync();
        {   PHASE_BEGIN
            const float* ada_l = ADA + (size_t)l * NSEQ * NADA;
#if PHASES & 4
            GEMM_PHASE(EpiResid, U, ws + WS_W2A, MTOK, DM, DFF, DFF, DFF, XW, ada_l + 2 * 1024, 0.5f)
#endif
        }
        grid.sync();
        {   PHASE_BEGIN
            const float* ada_l = ADA + (size_t)l * NSEQ * NADA;
            rmsmod_phase(XW, XW + (size_t)NPROMPT * DM, nullptr, ap->in[13] + l * DM, ada_l, 3, H, gw, NGW, lane); }
        grid.sync();
        {   PHASE_BEGIN
#if PHASES & 16
            GEMM_PHASE(EpiWin, H, ws + WS_WIN, MTOK, INCOLS, 1024, 1024, 1024, ws)
#endif
        }
        grid.sync();
        {
            PHASE_BEGIN
            const bf16* Qb = (const bf16*)(ws + WS_Q); const bf16* Kb = (const bf16*)(ws + WS_K); const bf16* Vb = (const bf16*)(ws + WS_V); bf16* Gb = (bf16*)(ws + WS_G);
            bf16* XCS = H; float* out = XW;
            const float* gn_g = ap->in[16] + l * 1024;
            if (bid < 64) {
#if PHASES & 32
                ret_prompt_unit(lds, Qb, Kb, Vb, Gb, ROPE, gn_g, out + O_RETP + ((size_t)l * 64 + bid) * 8192, bid >> 3, bid & 7, tid);
#endif
            } else {
                const int nb = G - 64;
#pragma unroll 1
                for (int u = bid - 64; u < 1024 + 1024 + 128 + 272; u += nb) {
                    if (u < 1024) { const int bs = u >> 3, h = u & 7;
#if PHASES & 64
                        ret_sample_unit(lds, Qb, Kb, Vb, Gb, ROPE, gn_g, ap->in[4] + (((size_t)l * 128 + bs) * 8 + h) * 8192, out + O_RETS + (((size_t)l * 128 + bs) * 8 + h) * 8192, bs, h, tid);
#endif
                    } else if (u < 2048) { const int v = u - 1024, b = v >> 7, ti = v & 127;
#if PHASES & 128
                        conf_unit<16>(lds, (const bf16*)(ws + WS_CA), (const bf16*)(ws + WS_CB), XCS, ap->in[18] + l * 31 * 512, ap->in[19] + l * 512, ap->in[20] + l * 512, ap->in[21] + l * 512,
                                      nullptr, out + O_CONFP + ((size_t)l * 8 + b) * 30 * 512, b * 2048, ti * 16, 2048, tid);
#endif
                    } else if (u < 2176) { const int bs = u - 2048;
#if PHASES & 128
                        conf_unit<8>(lds, (const bf16*)(ws + WS_CA), (const bf16*)(ws + WS_CB), XCS, ap->in[18] + l * 31 * 512, ap->in[19] + l * 512, ap->in[20] + l * 512, ap->in[21] + l * 512,
                                     ap->in[5] + ((size_t)l * 128 + bs) * 30 * 512, out + O_CONFS + ((size_t)l * 128 + bs) * 30 * 512, NPROMPT + bs * 8, 0, 8, tid);
#endif
                    } else {
#if PHASES & 256
                        sconv_unit((const bf16*)(ws + WS_SB), (const bf16*)(ws + WS_SCC), (const bf16*)(ws + WS_SX), XCS, ap->in[23] + l * 3 * 512, ap->in[6] + (size_t)l * 128 * 2 * 512,
                                   out + O_SCP + (size_t)l * 8 * 2 * 512, out + O_SCS + (size_t)l * 128 * 2 * 512, u - 2176, tid);
#endif
                    }
                }
            }
        }
        grid.sync();
#if PHASES & 512
        {   PHASE_BEGIN
            GEMM_PHASE(EpiBranch<0>, ws + WS_G, ws + WS_WRET, MTOK, DM, 1024, 1024, 1024, (const bf16*)(ws + WS_GL), ap->in[15] + l * 3072, (float*)(ws + WS_M32), (bf16*)(ws + WS_MBF), 0) }
#endif
        grid.sync();
#if PHASES & 512
        {   PHASE_BEGIN
            GEMM_PHASE(EpiBranch<1>, H, ws + WS_WCONF, MTOK, DM, 512, 1024, 512, (const bf16*)(ws + WS_GL), ap->in[15] + l * 3072, (float*)(ws + WS_M32), (bf16*)(ws + WS_MBF), 1) }
#endif
        grid.sync();
#if PHASES & 512
        {   PHASE_BEGIN
            GEMM_PHASE(EpiBranch<2>, H + 512, ws + WS_WSC, MTOK, DM, 512, 1024, 512, (const bf16*)(ws + WS_GL), ap->in[15] + l * 3072, (float*)(ws + WS_M32), (bf16*)(ws + WS_MBF), 2) }
#endif
        grid.sync();
        {   PHASE_BEGIN
            const float* ada_l = ADA + (size_t)l * NSEQ * NADA;
#if PHASES & 4
            GEMM_PHASE(EpiResid, ws + WS_MBF, ws + WS_WO, MTOK, DM, 1024, 1024, 1024, XW, ada_l + 5 * 1024, 1.0f)
#endif
        }
        grid.sync();
        {   PHASE_BEGIN
            const float* ada_l = ADA + (size_t)l * NSEQ * NADA;
            rmsmod_phase(XW, XW + (size_t)NPROMPT * DM, nullptr, ap->in[26] + l * DM, ada_l, 6, H, gw, NGW, lane); }
        grid.sync();
        {   PHASE_BEGIN
#if PHASES & 2
            GEMM_PHASE(EpiSwiglu, H, ws + WS_W13B, MTOK, 2 * DFF, 1024, 1024, 1024, U)
#ifdef PROBE_UP
            GEMM_PHASE(EpiSwiglu, H, ws + WS_W13B, MTOK, 2 * DFF, 1024, 1024, 1024, U)
#endif
#endif
        }
        grid.sync();
        {   PHASE_BEGIN
            const float* ada_l = ADA + (size_t)l * NSEQ * NADA;
#if PHASES & 4
            GEMM_PHASE(EpiResid, U, ws + WS_W2B, MTOK, DM, DFF, DFF, DFF, XW, ada_l + 8 * 1024, 0.5f)
#endif
        }
        grid.sync();
    }
    {   PHASE_BEGIN
        final_norm_phase(XW, ap->in[30], gw, NGW, lane); }
}

extern "C" void kernel_launch(void* const* d_in, const int* in_sizes, int n_in, void* d_out, int out_size, void* d_ws, size_t ws_size, hipStream_t stream) {
    static int grid = 0;
    if (grid == 0) {
        if (n_in != 31 || out_size != (int)O_END || ws_size < WS_END) { fprintf(stderr, "kernel_launch: unexpected shapes (n_in %d, out %d, ws %zu)\n", n_in, out_size, ws_size); grid = -1; return; }
        int dev = 0, cus = 0, per_cu = 0;
        if (hipGetDevice(&dev) != hipSuccess || hipDeviceGetAttribute(&cus, hipDeviceAttributeMultiprocessorCount, dev) != hipSuccess) { grid = -1; return; }
        if (hipFuncSetAttribute((const void*)mega_fwd, hipFuncAttributeMaxDynamicSharedMemorySize, LDS_BYTES) != hipSuccess) { fprintf(stderr, "kernel_launch: hipFuncSetAttribute failed\n"); grid = -1; return; }
        if (hipOccupancyMaxActiveBlocksPerMultiprocessor(&per_cu, (const void*)mega_fwd, NTHREADS, LDS_BYTES) != hipSuccess || per_cu < 1) { fprintf(stderr, "kernel_launch: occupancy query failed (%d)\n", per_cu); (void)hipGetLastError(); grid = -1; return; }
        grid = cus * per_cu;
        if (grid < 128) { fprintf(stderr, "kernel_launch: grid %d too small\n", grid); grid = -1; return; }
    }
    if (grid < 0) return;
    Args a{};
    for (int i = 0; i < 31; ++i) a.in[i] = (const float*)d_in[i];
    a.out = (float*)d_out; a.ws = (unsigned char*)d_ws;
    void* args[] = {&a};
    hipError_t e = hipLaunchCooperativeKernel((const void*)mega_fwd, dim3(grid), dim3(NTHREADS), args, LDS_BYTES, stream);
    if (e != hipSuccess) fprintf(stderr, "kernel_launch: cooperative launch failed: %s (grid %d)\n", hipGetErrorString(e), grid);
}
```

```cpp
#include <hip/hip_runtime.h>
#include <hip/hip_cooperative_groups.h>
#include <cstdio>
#include <cstdint>
namespace cg = cooperative_groups;
namespace pg8 {
#define PG8_LAS __attribute__((address_space(3)))
typedef unsigned short bf16_t;
typedef short bf16x8 __attribute__((ext_vector_type(8)));
typedef float f32x4 __attribute__((ext_vector_type(4)));
typedef unsigned u32x4 __attribute__((ext_vector_type(4)));
constexpr int BM = 256, BK = 64, HALF = 128, HTB = HALF * BK * 2  , STAGE_BYTES = 8 * HTB, NXCD = 8, WGM = 8;

__host__ __device__ __forceinline__ int lds_byte(int r, int c) { const int st = (r >> 4) * 2 + (c >> 5), rr = r & 15, cc = c & 31, ob = rr * 64 + cc * 2; return st * 1024 + (ob ^ (((ob >> 9) & 1) << 5)); }
__host__ __device__ __forceinline__ void stage_rc(int b, int& R, int& C) { const int st = b / 1024, sb = b % 1024, swz = sb ^ (((sb >> 9) & 1) << 5); R = (st >> 1) * 16 + swz / 64; C = (st & 1) * 32 + (swz % 64) / 2; }
__host__ __device__ __forceinline__ int perm32(int rho) { const int n = rho >> 4, i = rho & 15; return 8 * (i >> 2) + 4 * n + (i & 3); }

struct Unit { int pm, pn; };
struct Gemm { const bf16_t* A; const bf16_t* Bt; int M, N, K, lda, ldb; };

struct StaticOrder {
    int nM, nN, nwg, G, c;
    __host__ __device__ void init(int M, int N, int G_, int c_) { nM = M / BM; nN = N / BM; nwg = nM * nN; G = G_; c = c_; }
    __host__ __device__ bool next(int i, Unit& u) const {
        const long L = (long)i * G + c; if (L >= nwg) return false;
        int wgid = (int)L; { const int q = nwg / NXCD, r = nwg % NXCD, xcd = wgid % NXCD, off = wgid / NXCD; wgid = (xcd < r ? xcd * (q + 1) : r * (q + 1) + (xcd - r) * q) + off; }
        const int nig = WGM * nN, gid = wgid / nig, fm = gid * WGM, gsz = (nM - fm) < WGM ? (nM - fm) : WGM;
        u.pm = fm + ((wgid % nig) % gsz); u.pn = (wgid % nig) / gsz; return true;
    }
    __device__ __forceinline__ void a_ready(const Unit&) const {}
    __device__ __forceinline__ void done(const Unit&) const {}
};


__device__ __forceinline__ unsigned cvt_pk_bf16(float lo, float hi) { unsigned r; asm volatile("v_cvt_pk_bf16_f32 %0, %1, %2" : "=v"(r) : "v"(lo), "v"(hi)); return r; }
typedef float f32x2 __attribute__((ext_vector_type(2)));

template <class Epi, class Sched, bool ALIGN_EPI = false, bool SP2 = false>
__device__ __forceinline__ void gemm_phase(PG8_LAS unsigned char* lds, const Gemm g, const Sched& S, const Epi& E) {
    int tid_ = threadIdx.x; asm volatile("" : "+v"(tid_)); const int tid = tid_, wid = __builtin_amdgcn_readfirstlane(tid >> 6), lane = tid & 63, wr = wid >> 2, wc = wid & 3, fr = lane & 15, fq = lane >> 4;
    const int K = g.K, nt = K / BK;
    unsigned voffA[2], voffB[2];
#pragma unroll
    for (int i = 0; i < 2; ++i) { int R, C; stage_rc(tid * 16 + i * 8192, R, C); const int Rb = Epi::PERM ? ((R & ~31) + perm32(R & 31)) : R;
        voffA[i] = (unsigned)(R * g.lda + C) * 2u; voffB[i] = (unsigned)(Rb * g.ldb + C) * 2u; }
    const size_t kstep = (size_t)(BK * 2);
    const size_t hstepA = (size_t)HALF * g.lda * 2, hstepB = (size_t)HALF * g.ldb * 2;
    const size_t tstepA = 2 * hstepA, tstepB = 2 * hstepB;
    const unsigned ldsw = (unsigned)wid * 1024u;
    const int aoff = lds_byte(wr * 64 + fr, fq * 8), boff = lds_byte(wc * 32 + fr, fq * 8);
#define PG8_SA(b, h) (((b) * 2 + (h)) * HTB)
#define PG8_SB(b, h) ((4 + (b) * 2 + (h)) * HTB)
#define PG8_STAGE(bufoff, gbase, voff) do { _Pragma("unroll") for (int _i = 0; _i < 2; ++_i) \
        __builtin_amdgcn_global_load_lds((const unsigned*)((const char*)(gbase) + (voff)[_i]), (PG8_LAS unsigned*)(lds + (bufoff) + ldsw + _i * 8192), 16, 0, 0); } while (0)
#define PG8_LDA(dst, b, h) do { _Pragma("unroll") for (int m = 0; m < 4; ++m) _Pragma("unroll") for (int k = 0; k < 2; ++k) dst[m][k] = *(const PG8_LAS bf16x8*)(lds + PG8_SA(b, h) + aoff + m * 2048 + k * 1024); } while (0)
#define PG8_LDB(dst, b, h) do { _Pragma("unroll") for (int n = 0; n < 2; ++n) _Pragma("unroll") for (int k = 0; k < 2; ++k) dst[n][k] = *(const PG8_LAS bf16x8*)(lds + PG8_SB(b, h) + boff + n * 2048 + k * 1024); } while (0)
#define PG8_MMA(ai, bj, At, Bt) do { __builtin_amdgcn_s_setprio(1); _Pragma("unroll") for (int m = 0; m < 4; ++m) _Pragma("unroll") for (int n = 0; n < 2; ++n) _Pragma("unroll") for (int k = 0; k < 2; ++k) \
        acc[ai][bj][m][n] = __builtin_amdgcn_mfma_f32_16x16x32_bf16(Bt[n][k], At[m][k], acc[ai][bj][m][n], 0, 0, 0); __builtin_amdgcn_s_setprio(0); } while (0)
#define PG8_WAIT_V(n) asm volatile("s_waitcnt vmcnt(" #n ")" ::: "memory")
#define PG8_WAIT_L(n) asm volatile("s_waitcnt lgkmcnt(" #n ")" ::: "memory")
#define PG8_BAR __builtin_amdgcn_s_barrier()
#define PG8_SCHED __builtin_amdgcn_sched_barrier(0)
    Unit cur, nxt; int ui = 0;
    if (!S.next(0, cur)) return;
    f32x4 acc[2][2][4][2];
#pragma unroll
    for (int a = 0; a < 2; ++a)
#pragma unroll
        for (int b = 0; b < 2; ++b)
#pragma unroll
            for (int m = 0; m < 4; ++m)
#pragma unroll
                for (int n = 0; n < 2; ++n) acc[a][b][m][n] = (f32x4){0.f, 0.f, 0.f, 0.f};
    bf16x8 At[4][2], B0[2][2], B1[2][2];
    const char* cA = (const char*)g.A + (size_t)cur.pm * tstepA; const char* cB = (const char*)g.Bt + (size_t)cur.pn * tstepB;
    S.a_ready(cur);
    if constexpr (SP2) {
        PG8_STAGE(PG8_SB(0, 0), cB, voffB); PG8_STAGE(PG8_SB(0, 1), cB + hstepB, voffB); PG8_STAGE(PG8_SA(0, 0), cA, voffA); PG8_STAGE(PG8_SA(0, 1), cA + hstepA, voffA);
        if (wr == 1) PG8_BAR;
        PG8_WAIT_V(2); PG8_BAR;
        PG8_STAGE(PG8_SB(1, 0), cB + kstep, voffB); PG8_STAGE(PG8_SA(1, 0), cA + kstep, voffA); PG8_STAGE(PG8_SB(1, 1), cB + hstepB + kstep, voffB);
        PG8_WAIT_V(6); PG8_BAR;
    } else {
        PG8_STAGE(PG8_SB(0, 0), cB, voffB); PG8_STAGE(PG8_SA(0, 0), cA, voffA); PG8_STAGE(PG8_SB(0, 1), cB + hstepB, voffB); PG8_STAGE(PG8_SA(0, 1), cA + hstepA, voffA);
        if (wr == 1) PG8_BAR;
        PG8_WAIT_V(4); PG8_BAR;
        PG8_STAGE(PG8_SB(1, 0), cB + kstep, voffB); PG8_STAGE(PG8_SA(1, 0), cA + kstep, voffA); PG8_STAGE(PG8_SB(1, 1), cB + hstepB + kstep, voffB);
        PG8_WAIT_V(6); PG8_BAR;
    }
    for (;;) {
        const bool has_next = S.next(ui + 1, nxt);
        const char* nA = has_next ? (const char*)g.A + (size_t)nxt.pm * tstepA : cA; const char* nB = has_next ? (const char*)g.Bt + (size_t)nxt.pn * tstepB : cB;
        for (int t = 0; t < nt; t += 2) {
            const bool last = (t == nt - 2);
            const char* a1 = cA + (size_t)(t + 1) * kstep;
            const char* a2 = last ? nA : cA + (size_t)(t + 2) * kstep; const char* b2 = last ? nB : cB + (size_t)(t + 2) * kstep;
            const char* a3 = a2 + kstep; const char* b3 = b2 + kstep;
            if (last && has_next) S.a_ready(nxt);
            if constexpr (SP2) {
            PG8_LDB(B0, 0, 0); PG8_LDB(B1, 0, 1); PG8_SCHED; PG8_LDA(At, 0, 0); PG8_STAGE(PG8_SA(1, 1), a1 + hstepA, voffA);
            PG8_WAIT_V(8); PG8_WAIT_L(0); PG8_BAR; PG8_MMA(0, 0, At, B0); PG8_MMA(0, 1, At, B1); PG8_BAR; PG8_SCHED;
            PG8_LDA(At, 0, 1); PG8_STAGE(PG8_SB(0, 0), b2, voffB); PG8_STAGE(PG8_SB(0, 1), b2 + hstepB, voffB); PG8_STAGE(PG8_SA(0, 0), a2, voffA);
            PG8_WAIT_V(8); PG8_WAIT_L(0); PG8_BAR; PG8_MMA(1, 0, At, B0); PG8_MMA(1, 1, At, B1); PG8_BAR; PG8_SCHED;
            PG8_LDB(B0, 1, 0); PG8_LDB(B1, 1, 1); PG8_SCHED; PG8_LDA(At, 1, 0); PG8_STAGE(PG8_SA(0, 1), a2 + hstepA, voffA);
            PG8_WAIT_V(8); PG8_WAIT_L(0); PG8_BAR; PG8_MMA(0, 0, At, B0); PG8_MMA(0, 1, At, B1); PG8_BAR; PG8_SCHED;
            PG8_LDA(At, 1, 1); PG8_STAGE(PG8_SB(1, 0), b3, voffB); PG8_STAGE(PG8_SB(1, 1), b3 + hstepB, voffB); PG8_STAGE(PG8_SA(1, 0), a3, voffA);
            PG8_WAIT_V(8); PG8_WAIT_L(0); PG8_BAR; PG8_MMA(1, 0, At, B0); PG8_MMA(1, 1, At, B1); PG8_BAR; PG8_SCHED;
            } else {
            PG8_LDB(B0, 0, 0); PG8_SCHED; PG8_LDA(At, 0, 0); PG8_STAGE(PG8_SA(1, 1), a1 + hstepA, voffA);
            PG8_WAIT_L(8); PG8_BAR; PG8_WAIT_L(0); PG8_MMA(0, 0, At, B0); PG8_BAR; PG8_SCHED;
            PG8_LDB(B1, 0, 1); PG8_STAGE(PG8_SB(0, 0), b2, voffB);
            PG8_BAR; PG8_WAIT_L(0); PG8_MMA(0, 1, At, B1); PG8_BAR;
            PG8_LDA(At, 0, 1); PG8_STAGE(PG8_SA(0, 0), a2, voffA);
            PG8_BAR; PG8_WAIT_L(0); PG8_MMA(1, 0, At, B0); PG8_BAR; PG8_SCHED;
            PG8_STAGE(PG8_SB(0, 1), b2 + hstepB, voffB);
            PG8_WAIT_V(6); PG8_BAR; PG8_MMA(1, 1, At, B1); PG8_BAR;
            PG8_LDB(B0, 1, 0); PG8_SCHED; PG8_LDA(At, 1, 0); PG8_STAGE(PG8_SA(0, 1), a2 + hstepA, voffA);
            PG8_WAIT_L(8); PG8_BAR; PG8_WAIT_L(0); PG8_MMA(0, 0, At, B0); PG8_BAR; PG8_SCHED;
            PG8_LDB(B1, 1, 1); PG8_STAGE(PG8_SB(1, 0), b3, voffB);
            PG8_BAR; PG8_WAIT_L(0); PG8_MMA(0, 1, At, B1); PG8_BAR;
            PG8_LDA(At, 1, 1); PG8_STAGE(PG8_SA(1, 0), a3, voffA);
            PG8_BAR; PG8_WAIT_L(0); PG8_MMA(1, 0, At, B0); PG8_BAR; PG8_SCHED;
            PG8_STAGE(PG8_SB(1, 1), b3 + hstepB, voffB);
            PG8_WAIT_V(6); PG8_BAR; PG8_MMA(1, 1, At, B1); PG8_BAR;
            }
        }
        if constexpr (ALIGN_EPI) { if (wr == 0) PG8_BAR; }
        if constexpr (!Epi::AFTER_DRAIN) { E(acc, cur, wr, wc, fr, fq); S.done(cur); }
        if (!has_next) break;
#pragma unroll
        for (int a = 0; a < 2; ++a)
#pragma unroll
            for (int b = 0; b < 2; ++b)
#pragma unroll
                for (int m = 0; m < 4; ++m)
#pragma unroll
                    for (int n = 0; n < 2; ++n) acc[a][b][m][n] = (f32x4){0.f, 0.f, 0.f, 0.f};
        cur = nxt; cA = nA; cB = nB; ++ui;
        if constexpr (ALIGN_EPI) { if (wr == 1) PG8_BAR; }
    }
    PG8_WAIT_V(0);
    if constexpr (!ALIGN_EPI) { if (wr == 0) PG8_BAR; }
    PG8_BAR;
    if constexpr (Epi::AFTER_DRAIN) { E.fused(acc, cur, wr, wc, fr, fq, lds, wid, lane); S.done(cur); }
#undef PG8_SA
#undef PG8_SB
#undef PG8_STAGE
#undef PG8_LDA
#undef PG8_LDB
#undef PG8_MMA
#undef PG8_WAIT_V
#undef PG8_WAIT_L
#undef PG8_BAR
#undef PG8_SCHED
}
}
#ifndef PHASES
#define PHASES 0xFFFF
#endif

#define LAS __attribute__((address_space(3)))
typedef unsigned short bf16;
typedef float f32x4 __attribute__((ext_vector_type(4)));
typedef short bf16x8 __attribute__((ext_vector_type(8)));
typedef unsigned u32x4 __attribute__((ext_vector_type(4)));
typedef unsigned u32x2 __attribute__((ext_vector_type(2)));

constexpr int NPROMPT = 8 * 2048, NSAMPLE = 128 * 8, MTOK = NPROMPT + NSAMPLE;
constexpr int DM = 1024, DFF = 2816, NADA = 9216, NSEQ = 136, INCOLS = 8704;
constexpr int NTHREADS = 512, NWAVES = 8;

constexpr size_t MiB = 1u << 20;
constexpr size_t WS_ADA = 0, WS_CSIL = 10 * MiB, WS_ROPE = 11 * MiB;
constexpr size_t WS_W13A = 12 * MiB, WS_W2A = 23 * MiB, WS_W13B = 29 * MiB, WS_W2B = 40 * MiB, WS_WIN = 46 * MiB;
constexpr size_t WS_WRET = 63 * MiB, WS_WCONF = 65 * MiB, WS_WSC = 66 * MiB, WS_WO = 67 * MiB;
constexpr size_t WS_H = 69 * MiB;
constexpr size_t WS_Z = 103 * MiB;
constexpr size_t WS_Q = WS_Z, WS_K = WS_Z + 17 * MiB, WS_V = WS_Z + 34 * MiB, WS_G = WS_Z + 68 * MiB;
constexpr size_t WS_CA = WS_Z + 102 * MiB, WS_CB = WS_Z + 119 * MiB, WS_SB = WS_Z + 136 * MiB, WS_SCC = WS_Z + 153 * MiB, WS_SX = WS_Z + 170 * MiB;
constexpr size_t WS_GL = WS_Z + 187 * MiB;
constexpr size_t WS_KVB = WS_GL + 102 * MiB;
constexpr size_t WS_BAR = WS_KVB + 32 * MiB;
constexpr size_t WS_BAR_BYTES = 65536;
constexpr size_t WS_END = WS_BAR + WS_BAR_BYTES;
constexpr size_t WS_SCB = WS_SX;
constexpr size_t WS_U = WS_Z;
constexpr size_t WS_WADA = WS_Z;
constexpr size_t WS_M32 = WS_CA;
constexpr size_t WS_MBF = WS_V;

constexpr size_t O_Y = 0, O_RETP = 17825792, O_RETS = 18874368, O_CONFP = 35651584, O_CONFS = 35897344, O_SCP = 39829504, O_SCS = 39845888, O_END = 40108032;

constexpr int LDS_BYTES = 147456;

__device__ __forceinline__ unsigned f2bf(float f) { unsigned u = __builtin_bit_cast(unsigned, f); return (u + 0x7fffu + ((u >> 16) & 1u)) >> 16; }
__device__ __forceinline__ unsigned pk2(float lo, float hi) { return f2bf(lo) | (f2bf(hi) << 16); }
__device__ __forceinline__ float bf2f(unsigned b) { return __builtin_bit_cast(float, b << 16); }
__device__ __forceinline__ float bflo(unsigned w) { return __builtin_bit_cast(float, w << 16); }
__device__ __forceinline__ float bfhi(unsigned w) { return __builtin_bit_cast(float, w & 0xffff0000u); }
__device__ __forceinline__ float sigmoidf_(float x) { return __builtin_amdgcn_rcpf(1.0f + __expf(-x)); }
__device__ __forceinline__ float siluf_(float x) { return x * sigmoidf_(x); }
__device__ __forceinline__ int seq_of_row(int row) { return row < NPROMPT ? (row >> 11) : 8 + ((row - NPROMPT) >> 3); }
__device__ __forceinline__ float wave_sum(float v) {
#pragma unroll
    for (int o = 1; o < 64; o <<= 1) v += __shfl_xor(v, o);
    return v;
}
__device__ __forceinline__ float lgamma_h(int h) {
    float r = -0.0317486983145803f;
    r = h == 1 ? -0.015748356968139168f : r; r = h == 2 ? -0.007843177461025893f : r; r = h == 3 ? -0.003913899321136329f : r;
    r = h == 4 ? -0.0019550348358033506f : r; r = h == 5 ? -0.0009770396478266127f : r; r = h == 6 ? -0.0004884004981088745f : r; r = h == 7 ? -0.0002441704321739145f : r;
    return r;
}

using pg8::Unit;
struct EpiSwiglu {
    static constexpr bool PERM = true, AFTER_DRAIN = false;
    bf16* U;
    __device__ __forceinline__ void operator()(const f32x4 (&acc)[2][2][4][2], const Unit& u, int wr, int wc, int fr, int fq) const {
        const int row0 = u.pm * 256 + wr * 64 + fr, ucol0 = u.pn * 128 + wc * 16 + 4 * fq;
#pragma unroll
        for (int ai = 0; ai < 2; ++ai)
#pragma unroll
            for (int m = 0; m < 4; ++m) { bf16* rowp = U + (size_t)(row0 + ai * 128 + m * 16) * DFF + ucol0;
#pragma unroll
                for (int bj = 0; bj < 2; ++bj) { const f32x4 v0 = acc[ai][bj][m][0], v1 = acc[ai][bj][m][1];
                    u32x2 w; w.x = pk2(siluf_(v0[0]) * v1[0], siluf_(v0[1]) * v1[1]); w.y = pk2(siluf_(v0[2]) * v1[2], siluf_(v0[3]) * v1[3]);
                    *(u32x2*)(rowp + bj * 64) = w; } }
    }
};
struct EpiResid {
    static constexpr bool PERM = false, AFTER_DRAIN = false;
    float* x; const float* gate; float coef;
    __device__ __forceinline__ void operator()(const f32x4 (&acc)[2][2][4][2], const Unit& u, int wr, int wc, int fr, int fq) const {
        const int col0 = u.pn * 256 + wc * 32 + 4 * fq;
#pragma unroll
        for (int ai = 0; ai < 2; ++ai)
#pragma unroll
            for (int m = 0; m < 4; ++m) { const int row = u.pm * 256 + ai * 128 + wr * 64 + m * 16 + fr; const float* gp = gate + (size_t)seq_of_row(row) * NADA + col0; float* xp = x + (size_t)row * DM + col0;
#pragma unroll
                for (int bj = 0; bj < 2; ++bj)
#pragma unroll
                    for (int n = 0; n < 2; ++n) { const int c = bj * 128 + n * 16; const f32x4 g4 = *(const f32x4*)(gp + c); const f32x4 xv = *(const f32x4*)(xp + c);
                        *(f32x4*)(xp + c) = xv + acc[ai][bj][m][n] * g4 * coef; } }
    }
};
template <int MODE> struct EpiBranch {
    static constexpr bool PERM = false, AFTER_DRAIN = false;
    const bf16* GL; const float* bgate; float* M32; bf16* MBF; int br;
    __device__ __forceinline__ void operator()(const f32x4 (&acc)[2][2][4][2], const Unit& u, int wr, int wc, int fr, int fq) const {
        const int col0 = u.pn * 256 + wc * 32 + 4 * fq;
#pragma unroll
        for (int ai = 0; ai < 2; ++ai)
#pragma unroll
            for (int m = 0; m < 4; ++m) { const int row = u.pm * 256 + ai * 128 + wr * 64 + m * 16 + fr;
#pragma unroll
                for (int bj = 0; bj < 2; ++bj)
#pragma unroll
                    for (int n = 0; n < 2; ++n) { const int c = col0 + bj * 128 + n * 16;
                        const u32x2 gw = *(const u32x2*)(GL + (size_t)row * 3072 + br * 1024 + c); const f32x4 bg = *(const f32x4*)(bgate + br * 1024 + c);
                        f32x4 g; g[0] = sigmoidf_(bflo(gw.x) + bg[0]); g[1] = sigmoidf_(bfhi(gw.x) + bg[1]); g[2] = sigmoidf_(bflo(gw.y) + bg[2]); g[3] = sigmoidf_(bfhi(gw.y) + bg[3]);
                        f32x4 v = g * acc[ai][bj][m][n];
                        float* mp = M32 + (size_t)row * DM + c;
                        if (MODE == 0) { *(f32x4*)mp = v; }
                        else if (MODE == 1) { *(f32x4*)mp = *(const f32x4*)mp + v; }
                        else { v = v + *(const f32x4*)mp; u32x2 w; w.x = pk2(v[0], v[1]); w.y = pk2(v[2], v[3]); *(u32x2*)(MBF + (size_t)row * DM + c) = w; } } }
    }
};
struct EpiWin {
    static constexpr bool PERM = true, AFTER_DRAIN = false;
    unsigned char* ws;
    __device__ __forceinline__ void operator()(const f32x4 (&acc)[2][2][4][2], const Unit& u, int wr, int wc, int fr, int fq) const {
        const int colt = u.pn * 256; size_t off; int ld, c0;
        if (colt < 512) { off = WS_Q; ld = 512; c0 = colt; }
        else if (colt < 1024) { off = WS_K; ld = 512; c0 = colt - 512; }
        else if (colt < 2048) { off = WS_V; ld = 1024; c0 = colt - 1024; }
        else if (colt < 3072) { off = WS_G; ld = 1024; c0 = colt - 2048; }
        else if (colt < 3584) { off = WS_CA; ld = 512; c0 = colt - 3072; }
        else if (colt < 4096) { off = WS_CB; ld = 512; c0 = colt - 3584; }
        else if (colt < 4608) { off = WS_SB; ld = 512; c0 = colt - 4096; }
        else if (colt < 5120) { off = WS_SCC; ld = 512; c0 = colt - 4608; }
        else if (colt < 5632) { off = WS_SX; ld = 512; c0 = colt - 5120; }
        else { off = WS_GL; ld = 3072; c0 = colt - 5632; }
        bf16* base = (bf16*)(ws + off);
        const int row0 = u.pm * 256 + wr * 64 + fr, col0 = c0 + wc * 32 + 8 * fq;
#pragma unroll
        for (int ai = 0; ai < 2; ++ai)
#pragma unroll
            for (int m = 0; m < 4; ++m) { bf16* rowp = base + (size_t)(row0 + ai * 128 + m * 16) * ld + col0;
#pragma unroll
                for (int bj = 0; bj < 2; ++bj) { const f32x4 v0 = acc[ai][bj][m][0], v1 = acc[ai][bj][m][1];
                    u32x4 w; w.x = pk2(v0[0], v0[1]); w.y = pk2(v0[2], v0[3]); w.z = pk2(v1[0], v1[1]); w.w = pk2(v1[2], v1[3]);
                    *(u32x4*)(rowp + bj * 128) = w; } }
    }
};
struct EpiAda {
    static constexpr bool PERM = false, AFTER_DRAIN = false;
    float* ADA; const float* bada;
    __device__ __forceinline__ void operator()(const f32x4 (&acc)[2][2][4][2], const Unit& u, int wr, int wc, int fr, int fq) const {
        const int l = u.pn / 36, col0 = (u.pn - l * 36) * 256 + wc * 32 + 4 * fq;
#pragma unroll
        for (int ai = 0; ai < 2; ++ai)
#pragma unroll
            for (int m = 0; m < 4; ++m) { const int row = ai * 128 + wr * 64 + m * 16 + fr;
                if (row < NSEQ) {
#pragma unroll
                    for (int bj = 0; bj < 2; ++bj)
#pragma unroll
                        for (int n = 0; n < 2; ++n) { const int c = col0 + bj * 128 + n * 16;
                            *(f32x4*)(ADA + ((size_t)l * NSEQ + row) * NADA + c) = acc[ai][bj][m][n] + *(const f32x4*)(bada + (size_t)l * NADA + c); } } }
    }
};

__device__ __forceinline__ void transpose_item(const float* W, int N, bf16* WT, int ldk, int mode, int row_off, LAS float* scr, int item, int lane) {
    const int nblk = N / 32, kb = item / nblk, nb = item % nblk, k0 = 64 * kb, n0 = 32 * nb;
#pragma unroll 8
    for (int i = 0; i < 32; ++i) { const int kk = 2 * i + (lane >> 5); scr[kk * 33 + (lane & 31)] = W[(size_t)(k0 + kk) * N + n0 + (lane & 31)]; }
    asm volatile("s_waitcnt lgkmcnt(0)" ::: "memory");
    const int c = lane & 7;
#pragma unroll
    for (int j = 0; j < 4; ++j) { const int n = (lane >> 3) + 8 * j; const LAS float* s = scr + (8 * c) * 33 + n; const int ng = n0 + n;
        const int row = mode == 0 ? row_off + ng : (((ng >> 2) << 3) + (mode == 2 ? 4 : 0) + (ng & 3));
        u32x4 o; o.x = pk2(s[0 * 33], s[1 * 33]); o.y = pk2(s[2 * 33], s[3 * 33]); o.z = pk2(s[4 * 33], s[5 * 33]); o.w = pk2(s[6 * 33], s[7 * 33]);
        *(u32x4*)(WT + (size_t)row * ldk + k0 + 8 * c) = o; }
    asm volatile("s_waitcnt lgkmcnt(0)" ::: "memory");
}

struct Args { const float* in[31]; float* out; unsigned char* ws; };
typedef const __attribute__((address_space(4))) Args* ArgsP;

#define CONV(Wp, Kk, Nn, WTp, ldk, mode, roff) { const int cnt_ = ((Kk) / 64) * ((Nn) / 32); if (r < cnt_) { transpose_item((Wp), (Nn), (WTp), (ldk), (mode), (roff), scr, r, lane); continue; } r -= cnt_; }
constexpr int LAYER_CONV_ITEMS = 6 * 1408 + 4352 + 512 + 256 + 256 + 512;
__device__ __forceinline__ void convert_layer_weights(ArgsP ap, unsigned char* ws, int l, LAS unsigned char* lds, int gw, int NGW, int wave, int lane) {
    LAS float* scr = (LAS float*)(lds + wave * 16384);
    const size_t ffo = (size_t)l * DM * DFF;
    for (int it = gw; it < LAYER_CONV_ITEMS; it += NGW) {
        int r = it;
        CONV(ap->in[10] + ffo, 1024, 2816, (bf16*)(ws + WS_W13A), 1024, 1, 0)
        CONV(ap->in[11] + ffo, 1024, 2816, (bf16*)(ws + WS_W13A), 1024, 2, 0)
        CONV(ap->in[12] + ffo, 2816, 1024, (bf16*)(ws + WS_W2A), 2816, 0, 0)
        CONV(ap->in[27] + ffo, 1024, 2816, (bf16*)(ws + WS_W13B), 1024, 1, 0)
        CONV(ap->in[28] + ffo, 1024, 2816, (bf16*)(ws + WS_W13B), 1024, 2, 0)
        CONV(ap->in[29] + ffo, 2816, 1024, (bf16*)(ws + WS_W2B), 2816, 0, 0)
        CONV(ap->in[14] + (size_t)l * DM * INCOLS, 1024, 8704, (bf16*)(ws + WS_WIN), 1024, 0, 0)
        CONV(ap->in[17] + (size_t)l * 1024 * 1024, 1024, 1024, (bf16*)(ws + WS_WRET), 1024, 0, 0)
        CONV(ap->in[22] + (size_t)l * 512 * 1024, 512, 1024, (bf16*)(ws + WS_WCONF), 512, 0, 0)
        CONV(ap->in[24] + (size_t)l * 512 * 1024, 512, 1024, (bf16*)(ws + WS_WSC), 512, 0, 0)
        transpose_item(ap->in[25] + (size_t)l * 1024 * 1024, 1024, (bf16*)(ws + WS_WO), 1024, 0, 0, scr, r, lane);
    }
}
__device__ __forceinline__ void convert_ada_weights(ArgsP ap, unsigned char* ws, LAS unsigned char* lds, int gw, int NGW, int wave, int lane) {
    LAS float* scr = (LAS float*)(lds + wave * 16384);
    for (int it = gw; it < 2 * 4608; it += NGW) { const int l = it / 4608, r = it - l * 4608;
        transpose_item(ap->in[7] + (size_t)l * DM * NADA, NADA, (bf16*)(ws + WS_WADA), 1024, 0, l * NADA, scr, r, lane); }
}

__device__ __forceinline__ void rmsmod_phase(const float* xp, const float* xs, float* xcopy, const float* gnorm, const float* ada_l, int sidx, bf16* H, int gw, int NGW, int lane) {
    for (int m = gw; m < MTOK; m += NGW) {
        const float* xrow = m < NPROMPT ? xp + (size_t)m * DM : xs + (size_t)(m - NPROMPT) * DM;
        const f32x4* xr = (const f32x4*)xrow + lane;
        f32x4 v[4]; float s = 0.f;
#pragma unroll
        for (int j = 0; j < 4; ++j) { v[j] = xr[64 * j]; s += (v[j][0] * v[j][0] + v[j][1] * v[j][1]) + (v[j][2] * v[j][2] + v[j][3] * v[j][3]); }
        const float rstd = 1.0f / sqrtf(wave_sum(s) * (1.f / DM) + 1e-6f);
        const float* sh = ada_l + (size_t)seq_of_row(m) * NADA + sidx * 1024; const float* sc = sh + 1024;
        if (xcopy) { f32x4* xc = (f32x4*)(xcopy + (size_t)m * DM) + lane;
#pragma unroll
            for (int j = 0; j < 4; ++j) xc[64 * j] = v[j]; }
        u32x2* o8 = (u32x2*)(H + (size_t)m * DM) + lane;
#pragma unroll
        for (int j = 0; j < 4; ++j) { const int c = 4 * (lane + 64 * j);
            const f32x4 g4 = *(const f32x4*)(gnorm + c), s4 = *(const f32x4*)(sh + c), c4 = *(const f32x4*)(sc + c);
            const f32x4 o = v[j] * rstd * g4 * (c4 + 1.0f) + s4;
            u32x2 w; w.x = pk2(o[0], o[1]); w.y = pk2(o[2], o[3]); o8[64 * j] = w; }
    }
}
__device__ __forceinline__ void final_norm_phase(float* x, const float* g, int gw, int NGW, int lane) {
    for (int m = gw; m < MTOK; m += NGW) {
        f32x4* xr = (f32x4*)(x + (size_t)m * DM) + lane;
        f32x4 v[4]; float s = 0.f;
#pragma unroll
        for (int j = 0; j < 4; ++j) { v[j] = xr[64 * j]; s += (v[j][0] * v[j][0] + v[j][1] * v[j][1]) + (v[j][2] * v[j][2] + v[j][3] * v[j][3]); }
        const float rstd = 1.0f / sqrtf(wave_sum(s) * (1.f / DM) + 1e-6f);
#pragma unroll
        for (int j = 0; j < 4; ++j) { const f32x4 g4 = *(const f32x4*)(g + 4 * (lane + 64 * j)); xr[64 * j] = v[j] * rstd * g4; }
    }
}

#define MFMA16(a, b, c) __builtin_amdgcn_mfma_f32_16x16x32_bf16((a), (b), (c), 0, 0, 0)
typedef short s16x4 __attribute__((ext_vector_type(4)));
__device__ __forceinline__ s16x4 trread(const LAS unsigned char* p) { return __builtin_amdgcn_ds_read_tr16_b64_v4i16((LAS s16x4*)p); }
__device__ __forceinline__ s16x4 ld8(const LAS unsigned char* p) { return *(const LAS s16x4*)p; }
__device__ __forceinline__ bf16x8 cat8(s16x4 a, s16x4 b) { return (bf16x8){a[0], a[1], a[2], a[3], b[0], b[1], b[2], b[3]}; }
constexpr int ST64 = 144, ST128 = 288, STY = 272;
constexpr int L2_QS = 0, L2_KS = 18432, L2_VS = 36864, L2_SS = 73728, L2_YS = 92160;

template <bool WITH_Q> __device__ __forceinline__ void ret_load_chunk(LAS unsigned char* lds, const bf16* Q, const bf16* K, const bf16* V, const float* rope, int row0, int pos0, int h, float lg, int tid) {
    const int i = tid >> 2, gq = tid & 3; const size_t rb = (size_t)(row0 + i) * 512 + h * 64 + 8 * gq;
    const u32x4 klo = *(const u32x4*)(K + rb), khi = *(const u32x4*)(K + rb + 32);
    u32x4 qlo = klo, qhi = khi; if (WITH_Q) { qlo = *(const u32x4*)(Q + rb); qhi = *(const u32x4*)(Q + rb + 32); }
    const f32x4* rp = (const f32x4*)(rope + ((size_t)(pos0 + i) * 32 + 8 * gq) * 2);
    const f32x4 r0 = rp[0], r1 = rp[1], r2 = rp[2], r3 = rp[3];
    u32x4 vv[4];
#pragma unroll
    for (int y = 0; y < 4; ++y) vv[y] = *(const u32x4*)(V + (size_t)(row0 + i) * 1024 + h * 128 + 32 * gq + 8 * y);
    const float cs[8] = {r0[0], r0[2], r1[0], r1[2], r2[0], r2[2], r3[0], r3[2]}, sn[8] = {r0[1], r0[3], r1[1], r1[3], r2[1], r2[3], r3[1], r3[3]};
    const unsigned ql[4] = {qlo.x, qlo.y, qlo.z, qlo.w}, qh[4] = {qhi.x, qhi.y, qhi.z, qhi.w}, kl[4] = {klo.x, klo.y, klo.z, klo.w}, kh[4] = {khi.x, khi.y, khi.z, khi.w};
    const float gi = __expf((float)i * lg) * 0.125f, gk = __expf(-(float)i * lg);
    float qa[8], qb[8], ka[8], kb[8];
#pragma unroll
    for (int x = 0; x < 8; ++x) {
        const float k1 = (x & 1) ? bfhi(kl[x >> 1]) : bflo(kl[x >> 1]), k2 = (x & 1) ? bfhi(kh[x >> 1]) : bflo(kh[x >> 1]);
        ka[x] = (k1 * cs[x] - k2 * sn[x]) * gk; kb[x] = (k1 * sn[x] + k2 * cs[x]) * gk;
        if (WITH_Q) { const float q1 = (x & 1) ? bfhi(ql[x >> 1]) : bflo(ql[x >> 1]), q2 = (x & 1) ? bfhi(qh[x >> 1]) : bflo(qh[x >> 1]);
            qa[x] = (q1 * cs[x] - q2 * sn[x]) * gi; qb[x] = (q1 * sn[x] + q2 * cs[x]) * gi; }
    }
    u32x4 t;
    LAS unsigned char* kr = lds + L2_KS + i * ST64 + 16 * gq;
    t.x = pk2(ka[0], ka[1]); t.y = pk2(ka[2], ka[3]); t.z = pk2(ka[4], ka[5]); t.w = pk2(ka[6], ka[7]); *(LAS u32x4*)kr = t;
    t.x = pk2(kb[0], kb[1]); t.y = pk2(kb[2], kb[3]); t.z = pk2(kb[4], kb[5]); t.w = pk2(kb[6], kb[7]); *(LAS u32x4*)(kr + 64) = t;
    if (WITH_Q) { LAS unsigned char* qr = lds + L2_QS + i * ST64 + 16 * gq;
        t.x = pk2(qa[0], qa[1]); t.y = pk2(qa[2], qa[3]); t.z = pk2(qa[4], qa[5]); t.w = pk2(qa[6], qa[7]); *(LAS u32x4*)qr = t;
        t.x = pk2(qb[0], qb[1]); t.y = pk2(qb[2], qb[3]); t.z = pk2(qb[4], qb[5]); t.w = pk2(qb[6], qb[7]); *(LAS u32x4*)(qr + 64) = t; }
#pragma unroll
    for (int y = 0; y < 4; ++y) *(LAS u32x4*)(lds + L2_VS + i * ST128 + 64 * gq + 16 * y) = vv[y];
}

__device__ __forceinline__ void ret_kv_unit(LAS unsigned char* lds, const bf16* K, const bf16* V, const float* rope, float* KVout, int b, int h, int c, int tid) {
    const float lg = lgamma_h(h);
    ret_load_chunk<false>(lds, K, K, V, rope, b * 2048 + c * 128, c * 128, h, lg, tid);
    __syncthreads();
    const int w = __builtin_amdgcn_readfirstlane(tid >> 6), lane = tid & 63, l15 = lane & 15, q4 = lane >> 4, qq = (lane >> 2) & 3, p = lane & 3;
    const int dt = w & 3, et0 = (w >> 2) * 4, rloc = 4 * q4 + qq;
    const LAS unsigned char* kA = lds + L2_KS + rloc * ST64 + (16 * dt + 4 * p) * 2;
    const LAS unsigned char* vB = lds + L2_VS + rloc * ST128 + (4 * p) * 2;
    f32x4 kv[4];
#pragma unroll
    for (int x = 0; x < 4; ++x) kv[x] = (f32x4){0.f, 0.f, 0.f, 0.f};
#pragma unroll
    for (int ks = 0; ks < 4; ++ks) { const bf16x8 a = cat8(trread(kA + (32 * ks) * ST64), trread(kA + (32 * ks + 16) * ST64));
#pragma unroll
        for (int x = 0; x < 4; ++x) { const bf16x8 bb = cat8(trread(vB + (32 * ks) * ST128 + 32 * (et0 + x)), trread(vB + (32 * ks + 16) * ST128 + 32 * (et0 + x))); kv[x] = MFMA16(a, bb, kv[x]); } }
#pragma unroll
    for (int x = 0; x < 4; ++x)
#pragma unroll
        for (int r = 0; r < 4; ++r) KVout[(16 * dt + 4 * q4 + r) * 128 + 16 * (et0 + x) + l15] = kv[x][r];
    __syncthreads();
}

__device__ __forceinline__ void ret_scan(const float* KVB, bf16* SCB, float* Sfin  , int gtid, int gthreads) {
    for (int idx = gtid; idx < 64 * 2048; idx += gthreads) { const int bh = idx >> 11, e4 = (idx & 2047) * 4; const float lg = lgamma_h(bh & 7);
        const float gam = __expf(lg), cd = __expf(128.f * lg), g127 = __expf(127.f * lg);
        const float* kvp = KVB + (size_t)bh * 16 * 8192 + e4; bf16* scp = SCB + (size_t)bh * 16 * 8192 + e4;
        f32x4 kvv[16];
#pragma unroll
        for (int c = 0; c < 16; ++c) kvv[c] = *(const f32x4*)(kvp + c * 8192);
        f32x4 acc = (f32x4){0.f, 0.f, 0.f, 0.f};
#pragma unroll
        for (int c = 0; c < 16; ++c) { u32x2 t; t.x = pk2(gam * acc[0], gam * acc[1]); t.y = pk2(gam * acc[2], gam * acc[3]); *(u32x2*)(scp + c * 8192) = t; acc = acc * cd + kvv[c] * g127; }
        *(f32x4*)(Sfin + (size_t)bh * 8192 + e4) = acc; }
}

__device__ __forceinline__ void ret_out_unit(LAS unsigned char* lds, const bf16* Q, const bf16* K, const bf16* V, bf16* G, const float* rope, const float* gn_g, const bf16* SC, int b, int h, int c, int tid) {
    const float lg = lgamma_h(h); const int row0 = b * 2048 + c * 128;
    ret_load_chunk<true>(lds, Q, K, V, rope, row0, c * 128, h, lg, tid);
#pragma unroll
    for (int y = 0; y < 2; ++y) { const int idx = tid + 512 * y, d = idx >> 4, ch = idx & 15; *(LAS u32x4*)(lds + L2_SS + d * ST128 + ch * 16) = *(const u32x4*)(SC + d * 128 + ch * 8); }
    __syncthreads();
    const int w = __builtin_amdgcn_readfirstlane(tid >> 6), lane = tid & 63, l15 = lane & 15, q4 = lane >> 4, qq = (lane >> 2) & 3, p = lane & 3;
    const int rloc = 4 * q4 + qq;
    const LAS unsigned char* qrow = lds + L2_QS + (16 * w + l15) * ST64 + 8 * q4;
    const bf16x8 Qf0 = cat8(ld8(qrow), ld8(qrow + 32)), Qf1 = cat8(ld8(qrow + 64), ld8(qrow + 96));
    const LAS unsigned char* vB = lds + L2_VS + rloc * ST128 + 8 * p;
    const LAS unsigned char* sB = lds + L2_SS + rloc * ST128 + 8 * p;
    f32x4 o[8];
#pragma unroll
    for (int et = 0; et < 8; ++et) o[et] = (f32x4){0.f, 0.f, 0.f, 0.f};
    const int irow = 16 * w + l15;
    for (int ks = 0; ks <= (w >> 1); ++ks) {
        const LAS unsigned char* k0 = lds + L2_KS + (32 * ks + l15) * ST64 + 8 * q4; const LAS unsigned char* k1 = k0 + 16 * ST64;
        f32x4 s0 = (f32x4){0.f, 0.f, 0.f, 0.f}, s1 = s0;
        s0 = MFMA16(cat8(ld8(k0), ld8(k0 + 32)), Qf0, s0); s0 = MFMA16(cat8(ld8(k0 + 64), ld8(k0 + 96)), Qf1, s0);
        s1 = MFMA16(cat8(ld8(k1), ld8(k1 + 32)), Qf0, s1); s1 = MFMA16(cat8(ld8(k1 + 64), ld8(k1 + 96)), Qf1, s1);
        const int j0 = 32 * ks + 4 * q4;
#pragma unroll
        for (int r = 0; r < 4; ++r) { s0[r] = (j0 + r <= irow) ? s0[r] : 0.f; s1[r] = (j0 + 16 + r <= irow) ? s1[r] : 0.f; }
        u32x4 pw; pw.x = pk2(s0[0], s0[1]); pw.y = pk2(s0[2], s0[3]); pw.z = pk2(s1[0], s1[1]); pw.w = pk2(s1[2], s1[3]);
        const bf16x8 pa = __builtin_bit_cast(bf16x8, pw);
#pragma unroll
        for (int et = 0; et < 8; ++et) { const bf16x8 bb = cat8(trread(vB + (32 * ks) * ST128 + 32 * et), trread(vB + (32 * ks + 16) * ST128 + 32 * et)); o[et] = MFMA16(pa, bb, o[et]); }
    }
#pragma unroll
    for (int ks = 0; ks < 2; ++ks) { const bf16x8 a = ks ? Qf1 : Qf0;
#pragma unroll
        for (int et = 0; et < 8; ++et) { const bf16x8 bb = cat8(trread(sB + (32 * ks) * ST128 + 32 * et), trread(sB + (32 * ks + 16) * ST128 + 32 * et)); o[et] = MFMA16(a, bb, o[et]); } }
    float gg[8];
#pragma unroll
    for (int et = 0; et < 8; ++et) gg[et] = gn_g[h * 128 + 16 * et + l15];
#pragma unroll
    for (int r = 0; r < 4; ++r) {
        float s = 0.f;
#pragma unroll
        for (int et = 0; et < 8; ++et) s += o[et][r];
        s += __shfl_xor(s, 1); s += __shfl_xor(s, 2); s += __shfl_xor(s, 4); s += __shfl_xor(s, 8);
        const float mean = s * (1.f / 128.f); float vs = 0.f;
#pragma unroll
        for (int et = 0; et < 8; ++et) { const float d = o[et][r] - mean; vs += d * d; }
        vs += __shfl_xor(vs, 1); vs += __shfl_xor(vs, 2); vs += __shfl_xor(vs, 4); vs += __shfl_xor(vs, 8);
        const float rstd = 1.0f / sqrtf(vs * (1.f / 128.f) + 1e-5f);
        LAS bf16* yr = (LAS bf16*)(lds + L2_YS + (16 * w + 4 * q4 + r) * STY) + l15;
#pragma unroll
        for (int et = 0; et < 8; ++et) yr[16 * et] = (bf16)f2bf((o[et][r] - mean) * rstd * gg[et]);
    }
#pragma unroll
    for (int y = 0; y < 4; ++y) { const int idx = lane + 64 * y, rr = 16 * w + (idx >> 4), ch = idx & 15;
        const u32x4 yv = *(const LAS u32x4*)(lds + L2_YS + rr * STY + ch * 16);
        bf16* gp = G + (size_t)(row0 + rr) * 1024 + h * 128 + ch * 8; const u32x4 gv = *(const u32x4*)gp;
        u32x4 ov;
        ov.x = pk2(siluf_(bflo(gv.x)) * bflo(yv.x), siluf_(bfhi(gv.x)) * bfhi(yv.x)); ov.y = pk2(siluf_(bflo(gv.y)) * bflo(yv.y), siluf_(bfhi(gv.y)) * bfhi(yv.y));
        ov.z = pk2(siluf_(bflo(gv.z)) * bflo(yv.z), siluf_(bfhi(gv.z)) * bfhi(yv.z)); ov.w = pk2(siluf_(bflo(gv.w)) * bflo(yv.w), siluf_(bfhi(gv.w)) * bfhi(yv.w));
        *(u32x4*)gp = ov; }
    __syncthreads();
}

__device__ __forceinline__ void ret_sample_unit(LAS unsigned char* lds, const bf16* Q, const bf16* K, const bf16* V, bf16* G, const float* rope, const float* gn_g, const float* S0, float* Sout, int bs, int h, int tid) {
    LAS float* qf = (LAS float*)lds; LAS float* kf = qf + 512; LAS float* vf = kf + 512; LAS float* sc = vf + 1024; LAS float* oc = sc + 64; LAS float* ob = oc + 4096;
    const int w = tid >> 6, lane = tid & 63; const float lg = lgamma_h(h); const int row0 = NPROMPT + bs * 8;
    {   const int which = tid >> 8, t2 = tid & 255, i = t2 >> 5, d = t2 & 31; const bf16* src = which ? K : Q; const size_t rb = (size_t)(row0 + i) * 512 + h * 64 + d;
        const float x1 = bf2f(src[rb]), x2 = bf2f(src[rb + 32]); const float cs = rope[((size_t)(2048 + i) * 32 + d) * 2], sn = rope[((size_t)(2048 + i) * 32 + d) * 2 + 1];
        const float scale = which ? 1.0f : 0.125f; LAS float* dst = which ? kf : qf;
        dst[i * 64 + d] = (x1 * cs - x2 * sn) * scale; dst[i * 64 + 32 + d] = (x1 * sn + x2 * cs) * scale; }
#pragma unroll
    for (int y = 0; y < 2; ++y) { const int idx = tid + 512 * y, j = idx >> 7, e = idx & 127; vf[idx] = bf2f(V[(size_t)(row0 + j) * 1024 + h * 128 + e]); }
    __syncthreads();
    if (tid < 64) { const int i = tid >> 3, j = tid & 7; float s = 0.f;
        if (j <= i) { for (int d = 0; d < 64; ++d) s += qf[i * 64 + d] * kf[j * 64 + d]; s *= __expf((float)(i - j) * lg); }
        sc[tid] = s; }
    const int e = tid & 127, dg = tid >> 7;
    float Sreg[16];
#pragma unroll
    for (int dd = 0; dd < 16; ++dd) Sreg[dd] = S0[(dg * 16 + dd) * 128 + e];
#pragma unroll
    for (int i = 0; i < 8; ++i) { float p = 0.f;
#pragma unroll
        for (int dd = 0; dd < 16; ++dd) p += qf[i * 64 + dg * 16 + dd] * Sreg[dd];
        oc[(dg * 8 + i) * 128 + e] = p; }
    const float g8 = __expf(8.f * lg);
    float vdec[8];
#pragma unroll
    for (int j = 0; j < 8; ++j) vdec[j] = __expf((float)(7 - j) * lg) * vf[j * 128 + e];
#pragma unroll
    for (int dd = 0; dd < 16; ++dd) { float acc = Sreg[dd] * g8;
#pragma unroll
        for (int j = 0; j < 8; ++j) acc += kf[j * 64 + dg * 16 + dd] * vdec[j];
        Sout[(dg * 16 + dd) * 128 + e] = acc; }
    __syncthreads();
#pragma unroll
    for (int y = 0; y < 2; ++y) { const int idx = tid + 512 * y, i = idx >> 7, ee = idx & 127;
        float o = (oc[(0 + i) * 128 + ee] + oc[(8 + i) * 128 + ee] + oc[(16 + i) * 128 + ee] + oc[(24 + i) * 128 + ee]) * __expf((float)(i + 1) * lg);
        for (int j = 0; j <= i; ++j) o += sc[i * 8 + j] * vf[j * 128 + ee];
        ob[idx] = o; }
    __syncthreads();
    {   const int i = w; const float v0 = ob[i * 128 + lane], v1 = ob[i * 128 + 64 + lane];
        const float mean = wave_sum(v0 + v1) * (1.f / 128.f); const float d0 = v0 - mean, d1 = v1 - mean;
        const float rstd = 1.0f / sqrtf(wave_sum(d0 * d0 + d1 * d1) * (1.f / 128.f) + 1e-5f);
        bf16* gp = G + (size_t)(row0 + i) * 1024 + h * 128 + lane;
        const float g0 = bf2f(gp[0]), g1 = bf2f(gp[64]);
        gp[0] = (bf16)f2bf(siluf_(g0) * d0 * rstd * gn_g[h * 128 + lane]); gp[64] = (bf16)f2bf(siluf_(g1) * d1 * rstd * gn_g[h * 128 + 64 + lane]); }
    __syncthreads();
}

template <int NT> __device__ __forceinline__ void conf_unit(LAS unsigned char* lds, const bf16* CA, const bf16* CB, bf16* XCS, const float* cw, const float* cbias, const float* lng, const float* lnb,
                                                             const float* state, float* state_out, int seqrow0, int t0, int T, int tid) {
    LAS float* U = (LAS float*)lds; LAS float* CV = U + 46 * 512;
    const int c = tid, w = tid >> 6, lane = tid & 63;
    float wreg[31];
#pragma unroll
    for (int k = 0; k < 31; ++k) wreg[k] = cw[k * 512 + c];
    const float bias = cbias[c];
    for (int it = tid; it < (30 + NT) * 64; it += NTHREADS) {
        const int r = it >> 6, c0 = (it & 63) * 8; f32x4 u0 = (f32x4){0.f, 0.f, 0.f, 0.f}, u1 = u0;
        if (state && r < 30) { u0 = *(const f32x4*)(state + r * 512 + c0); u1 = *(const f32x4*)(state + r * 512 + c0 + 4); }
        else { const int t = t0 - 30 + r;
            if (t >= 0) { const size_t gi = (size_t)(seqrow0 + t) * 512 + c0; const u32x4 av = *(const u32x4*)(CA + gi), bv = *(const u32x4*)(CB + gi);
                u0[0] = bflo(av.x) * sigmoidf_(bflo(bv.x)); u0[1] = bfhi(av.x) * sigmoidf_(bfhi(bv.x)); u0[2] = bflo(av.y) * sigmoidf_(bflo(bv.y)); u0[3] = bfhi(av.y) * sigmoidf_(bfhi(bv.y));
                u1[0] = bflo(av.z) * sigmoidf_(bflo(bv.z)); u1[1] = bfhi(av.z) * sigmoidf_(bfhi(bv.z)); u1[2] = bflo(av.w) * sigmoidf_(bflo(bv.w)); u1[3] = bfhi(av.w) * sigmoidf_(bfhi(bv.w));
                if (!state && r >= 30 && t >= T - 30) { float* so = state_out + (size_t)(t - (T - 30)) * 512 + c0; *(f32x4*)so = u0; *(f32x4*)(so + 4) = u1; } } }
        *(LAS f32x4*)(U + r * 512 + c0) = u0; *(LAS f32x4*)(U + r * 512 + c0 + 4) = u1;
    }
    __syncthreads();
    if (state) { for (int it = tid; it < 30 * 128; it += NTHREADS) { const int rr = it >> 7, c4 = (it & 127) * 4; *(f32x4*)(state_out + rr * 512 + c4) = *(const LAS f32x4*)(U + (rr + NT) * 512 + c4); } }
    float cv[NT];
#pragma unroll
    for (int tt = 0; tt < NT; ++tt) cv[tt] = bias;
#pragma unroll
    for (int r = 0; r < 30 + NT; ++r) { const float u = U[r * 512 + c];
#pragma unroll
        for (int tt = 0; tt < NT; ++tt) { if (r - tt >= 0 && r - tt <= 30) cv[tt] += wreg[r - tt] * u; } }
#pragma unroll
    for (int tt = 0; tt < NT; ++tt) CV[tt * 512 + c] = cv[tt];
    __syncthreads();
    for (int tt = w; tt < NT; tt += 8) {
        const f32x4 x0 = *(const LAS f32x4*)(CV + tt * 512 + lane * 8), x1 = *(const LAS f32x4*)(CV + tt * 512 + lane * 8 + 4);
        const float mean = wave_sum((x0[0] + x0[1]) + (x0[2] + x0[3]) + (x1[0] + x1[1]) + (x1[2] + x1[3])) * (1.f / 512.f);
        const f32x4 d0 = x0 - mean, d1 = x1 - mean;
        const float var = wave_sum((d0[0] * d0[0] + d0[1] * d0[1]) + (d0[2] * d0[2] + d0[3] * d0[3]) + (d1[0] * d1[0] + d1[1] * d1[1]) + (d1[2] * d1[2] + d1[3] * d1[3])) * (1.f / 512.f);
        const float rstd = 1.0f / sqrtf(var + 1e-5f);
        const f32x4 g0 = *(const f32x4*)(lng + lane * 8), g1 = *(const f32x4*)(lng + lane * 8 + 4), b0 = *(const f32x4*)(lnb + lane * 8), b1 = *(const f32x4*)(lnb + lane * 8 + 4);
        const f32x4 y0 = d0 * rstd * g0 + b0, y1 = d1 * rstd * g1 + b1;
        u32x4 o; o.x = pk2(siluf_(y0[0]), siluf_(y0[1])); o.y = pk2(siluf_(y0[2]), siluf_(y0[3])); o.z = pk2(siluf_(y1[0]), siluf_(y1[1])); o.w = pk2(siluf_(y1[2]), siluf_(y1[3]));
        *(u32x4*)(XCS + (size_t)(seqrow0 + t0 + tt) * 1024 + lane * 8) = o;
    }
    __syncthreads();
}

__device__ __forceinline__ void sconv_unit(const bf16* SB, const bf16* SCC, const bf16* SX, bf16* XCS, const float* scw, const float* state_l  , float* outp_l  , float* outs_l  , int tile, int tid) {
#pragma unroll 1
    for (int y = 0; y < 8; ++y) {
        const int item = tid + 512 * y, R = tile * 64 + (item >> 6), c0 = (item & 63) * 8;
        const bool prompt = R < NPROMPT; const int t = prompt ? (R & 2047) : ((R - NPROMPT) & 7); const int sq = prompt ? (R >> 11) : ((R - NPROMPT) >> 3);
        float us[3][8];
#pragma unroll
        for (int k = 0; k < 3; ++k) { const int tp = t - 2 + k;
            if (tp >= 0) { const size_t gi = (size_t)(R - 2 + k) * 512 + c0; const u32x4 a = *(const u32x4*)(SCC + gi), bq = *(const u32x4*)(SX + gi);
                const unsigned aw[4] = {a.x, a.y, a.z, a.w}, bw[4] = {bq.x, bq.y, bq.z, bq.w};
#pragma unroll
                for (int x = 0; x < 4; ++x) { us[k][2 * x] = bflo(aw[x]) * bflo(bw[x]); us[k][2 * x + 1] = bfhi(aw[x]) * bfhi(bw[x]); } }
            else if (prompt) {
#pragma unroll
                for (int x = 0; x < 8; ++x) us[k][x] = 0.f; }
            else { const float* sp = state_l + ((size_t)sq * 2 + (2 + tp)) * 512 + c0; const f32x4 s0 = *(const f32x4*)sp, s1 = *(const f32x4*)(sp + 4);
#pragma unroll
                for (int x = 0; x < 4; ++x) { us[k][x] = s0[x]; us[k][4 + x] = s1[x]; } } }
        const u32x4 sbv = *(const u32x4*)(SB + (size_t)R * 512 + c0); const unsigned sw[4] = {sbv.x, sbv.y, sbv.z, sbv.w};
        float o[8];
#pragma unroll
        for (int x = 0; x < 8; ++x) { const float sv = scw[c0 + x] * us[0][x] + scw[512 + c0 + x] * us[1][x] + scw[1024 + c0 + x] * us[2][x];
            o[x] = ((x & 1) ? bfhi(sw[x >> 1]) : bflo(sw[x >> 1])) * sv; }
        u32x4 ow; ow.x = pk2(o[0], o[1]); ow.y = pk2(o[2], o[3]); ow.z = pk2(o[4], o[5]); ow.w = pk2(o[6], o[7]);
        *(u32x4*)(XCS + (size_t)R * 1024 + 512 + c0) = ow;
        const int tl = prompt ? 2046 : 6;
        if (t >= tl) { float* op = (prompt ? outp_l : outs_l) + ((size_t)sq * 2 + (t - tl)) * 512 + c0;
            *(f32x4*)op = (f32x4){us[2][0], us[2][1], us[2][2], us[2][3]}; *(f32x4*)(op + 4) = (f32x4){us[2][4], us[2][5], us[2][6], us[2][7]}; }
    }
}


#define XB_TMO      128
#define XB_XCNT(j)  (256  + 64 * (j))
#define XB_XSUB(j)  (1280 + 64 * (j))
#define XB_XGEN(j)  (2304 + 64 * (j))
#define XB_TOP      3328
#define XB_TOPGEN   3392
#define XCD_BAR_WORDS 3456
#define XB_SPIN_CAP (1u << 18)

__device__ __forceinline__ unsigned xb_ld(unsigned* p)              { return __hip_atomic_load(p, __ATOMIC_RELAXED, __HIP_MEMORY_SCOPE_AGENT); }
__device__ __forceinline__ unsigned xb_add(unsigned* p, unsigned v) { return __hip_atomic_fetch_add(p, v, __ATOMIC_RELAXED, __HIP_MEMORY_SCOPE_AGENT); }
__device__ __forceinline__ unsigned xb_xcc_id() { return (unsigned)__builtin_amdgcn_s_getreg((3 << 11) | 20) & 0xFu; }
#define XB_SPIN(cond, bar) do { unsigned _sp = 0; while (cond) { __builtin_amdgcn_s_sleep(1); \
    if ((++_sp & 255u) == 0u) { if (xb_ld(&(bar)[XB_TMO])) break; if (_sp > XB_SPIN_CAP) { atomicAdd(&(bar)[XB_TMO], 1u); break; } } } } while (0)

struct XcdBarrier {
    unsigned* bar; unsigned x;
    volatile LAS unsigned* st;
};

__device__ __forceinline__ XcdBarrier xcd_barrier_post(unsigned* bar, volatile LAS unsigned* st) {
    XcdBarrier b; b.bar = bar; b.x = xb_xcc_id(); b.st = st;
    if (threadIdx.x == 0) (void)xb_add(&bar[XB_XCNT(b.x)], 1u);
    return b;
}
__device__ __forceinline__ void xcd_barrier_complete(unsigned* bar, unsigned x, unsigned& nloc, unsigned& nx) {
    const unsigned G = gridDim.x * gridDim.y * gridDim.z;
    unsigned sum, cnt, mine, sp = 0u;
    for (;;) {
        sum = 0u; cnt = 0u; mine = 0u;
#pragma unroll
        for (unsigned j = 0; j < 16; ++j) { const unsigned c = xb_ld(&bar[XB_XCNT(j)]); sum += c; cnt += (c > 0u) ? 1u : 0u; mine = (j == x) ? c : mine; }
        if (sum == G) break;
        __builtin_amdgcn_s_sleep(1);
        if ((++sp & 255u) == 0u) { if (xb_ld(&bar[XB_TMO])) break; if (sp > XB_SPIN_CAP) { atomicAdd(&bar[XB_TMO], 1u); break; } }
    }
    nloc = mine > 0u ? mine : 1u; nx = cnt > 0u ? cnt : 1u;
}

__device__ __forceinline__ void xcd_barrier(const XcdBarrier& b) {
    asm volatile("s_waitcnt vmcnt(0)" ::: "memory");
    __syncthreads();
    if (threadIdx.x == 0) {
        unsigned* bar = b.bar;
        __builtin_amdgcn_s_waitcnt(0);
        unsigned nloc = b.st[0], nx = b.st[1];
        if (nloc == 0u) { xcd_barrier_complete(bar, b.x, nloc, nx); b.st[0] = nloc; b.st[1] = nx; }
        const unsigned old = xb_add(&bar[XB_XSUB(b.x)], 1u);
        const unsigned gen = old / nloc;
        if (old + 1u == (gen + 1u) * nloc) {
            __builtin_amdgcn_fence(__ATOMIC_RELEASE, "agent");
            asm volatile("s_waitcnt vmcnt(0)" ::: "memory");
            const unsigned og = xb_add(&bar[XB_TOP], 1u);
            const unsigned tg = og / nx;
            if (og + 1u == (tg + 1u) * nx) xb_add(&bar[XB_TOPGEN], 1u);
            else XB_SPIN(xb_ld(&bar[XB_TOPGEN]) == tg, bar);
            __builtin_amdgcn_fence(__ATOMIC_ACQUIRE, "agent");
            xb_add(&bar[XB_XGEN(b.x)], 1u);
            asm volatile("s_waitcnt vmcnt(0)" ::: "memory");
        } else {
            XB_SPIN(xb_ld(&bar[XB_XGEN(b.x)]) == gen, bar);
            __builtin_amdgcn_fence(__ATOMIC_ACQUIRE, "agent");
            asm volatile("s_waitcnt vmcnt(0)" ::: "memory");
        }
    }
    __syncthreads();
}


__global__ void __launch_bounds__(NTHREADS, 2) mega_fwd(Args a) {
    extern __shared__ __attribute__((aligned(16))) unsigned char lds_raw[];
    cg::grid_group grid = cg::this_grid();
    LAS unsigned char* lds = (LAS unsigned char*)lds_raw;
    const int G = gridDim.x, bid0 = blockIdx.x, NGW = G * NWAVES;
    volatile LAS unsigned* bst = (volatile LAS unsigned*)(lds + 131072 + 64);
    if (threadIdx.x < 2) bst[threadIdx.x] = 0u;
    __syncthreads();
    const XcdBarrier xbar = xcd_barrier_post((unsigned*)(a.ws + WS_BAR), bst);
#define GRID_BAR() xcd_barrier(xbar)
#define PHASE_BEGIN ArgsP ap = (ArgsP)__builtin_amdgcn_kernarg_segment_ptr(); asm volatile("" : "+s"(ap)); unsigned char* ws = ap->ws; float* XW = ap->out; int tid = threadIdx.x; asm volatile("" : "+v"(tid)); int bid = bid0; asm volatile("" : "+s"(bid)); \
    const int lane = tid & 63, wave = __builtin_amdgcn_readfirstlane(tid >> 6), gw = bid * NWAVES + wave; \
    float* ADA = (float*)(ws + WS_ADA); float* ROPE = (float*)(ws + WS_ROPE); bf16* H = (bf16*)(ws + WS_H); bf16* U = (bf16*)(ws + WS_U); \
    (void)lane; (void)wave; (void)gw; (void)ADA; (void)ROPE; (void)H; (void)U; (void)XW;
#define GEMM_PHASE(EPI, Aptr, Bptr, Mm, Nn, Kk, lda_, ldb_, ...) { pg8::Gemm g{(const bf16*)(Aptr), (const bf16*)(Bptr), (Mm), (Nn), (Kk), (lda_), (ldb_)}; pg8::StaticOrder S; S.init((Mm), (Nn), G, bid); \
        EPI E{__VA_ARGS__}; pg8::gemm_phase<EPI, pg8::StaticOrder, true, true>(lds, g, S, E); }

    {   PHASE_BEGIN
#if PHASES & 1
        convert_ada_weights(ap, ws, lds, gw, NGW, wave, lane);
#endif
        bf16* CS = (bf16*)(ws + WS_CSIL);
        for (int i = bid * NTHREADS + tid; i < 256 * 1024; i += G * NTHREADS) { const int r = i >> 10, c = i & 1023; float v = 0.f;
            if (r < 8) v = siluf_(ap->in[2][r * 1024 + c]); else if (r < NSEQ) v = siluf_(ap->in[3][(r - 8) * 1024 + c]);
            CS[i] = (bf16)f2bf(v); }
        for (int i = bid * NTHREADS + tid; i < 2056 * 32; i += G * NTHREADS) { const int p = i >> 5, k = i & 31; const int pos = p < 2048 ? p : 16384 + (p - 2048);
            double f = 0.15915494309189535; for (int q = 0; q < k; ++q) f *= 0.7498942093324559;
            double rv = (double)pos * f; rv -= __builtin_floor(rv); const float fr = (float)rv;
            ROPE[2 * i] = __builtin_amdgcn_cosf(fr); ROPE[2 * i + 1] = __builtin_amdgcn_sinf(fr); }
#if PHASES & 1
        convert_layer_weights(ap, ws, 0, lds, gw, NGW, wave, lane);
#endif
    }
    grid.sync();
    {   PHASE_BEGIN
#if PHASES & 1024
        GEMM_PHASE(EpiAda, ws + WS_CSIL, ws + WS_WADA, 256, 2 * NADA, 1024, 1024, 1024, ADA, ap->in[8])
#endif
    }
    GRID_BAR();

#pragma unroll 1
    for (int l = 0; l < 2; ++l) {
        {   PHASE_BEGIN
            const float* ada_l = ADA + (size_t)l * NSEQ * NADA;
            if (l == 0) rmsmod_phase(ap->in[0], ap->in[1], XW, ap->in[9], ada_l, 0, H, gw, NGW, lane);
            else { rmsmod_phase(XW, XW + (size_t)NPROMPT * DM, nullptr, ap->in[9] + l * DM, ada_l, 0, H, gw, NGW, lane);
#if PHASES & 1
                convert_layer_weights(ap, ws, l, lds, gw, NGW, wave, lane);
#endif
            } }
        GRID_BAR();
        {   PHASE_BEGIN
#if PHASES & 2
            GEMM_PHASE(EpiSwiglu, H, ws + WS_W13A, MTOK, 2 * DFF, 1024, 1024, 1024, U)
#ifdef PROBE_UP
            GEMM_PHASE(EpiSwiglu, H, ws + WS_W13A, MTOK, 2 * DFF, 1024, 1024, 1024, U)
#endif
#endif
        }
        GRID_BAR();
        {   PHASE_BEGIN
            const float* ada_l = ADA + (size_t)l * NSEQ * NADA;
#if PHASES & 4
            GEMM_PHASE(EpiResid, U, ws + WS_W2A, MTOK, DM, DFF, DFF, DFF, XW, ada_l + 2 * 1024, 0.5f)
#endif
        }
        GRID_BAR();
        {   PHASE_BEGIN
            const float* ada_l = ADA + (size_t)l * NSEQ * NADA;
            rmsmod_phase(XW, XW + (size_t)NPROMPT * DM, nullptr, ap->in[13] + l * DM, ada_l, 3, H, gw, NGW, lane); }
        GRID_BAR();
        {   PHASE_BEGIN
#if PHASES & 16
            GEMM_PHASE(EpiWin, H, ws + WS_WIN, MTOK, INCOLS, 1024, 1024, 1024, ws)
#endif
        }
        GRID_BAR();
        {
            PHASE_BEGIN
            const bf16* Qb = (const bf16*)(ws + WS_Q); const bf16* Kb = (const bf16*)(ws + WS_K); const bf16* Vb = (const bf16*)(ws + WS_V); bf16* Gb = (bf16*)(ws + WS_G);
            bf16* XCS = H; float* out = XW;
            const float* gn_g = ap->in[16] + l * 1024;
#pragma unroll 1
            for (int u = bid; u < 1024 + 1024 + 1024 + 128 + 272; u += G) {
                if (u < 1024) { const int bh = u >> 4, c = u & 15;
                    ret_kv_unit(lds, Kb, Vb, ROPE, (float*)(ws + WS_KVB) + (size_t)u * 8192, bh >> 3, bh & 7, c, tid);
                } else if (u < 2048) { const int v = u - 1024, bs = v >> 3, h = v & 7;
                    ret_sample_unit(lds, Qb, Kb, Vb, Gb, ROPE, gn_g, ap->in[4] + (((size_t)l * 128 + bs) * 8 + h) * 8192, out + O_RETS + (((size_t)l * 128 + bs) * 8 + h) * 8192, bs, h, tid);
                } else if (u < 3072) { const int v = u - 2048, b = v >> 7, ti = v & 127;
                    conf_unit<16>(lds, (const bf16*)(ws + WS_CA), (const bf16*)(ws + WS_CB), XCS, ap->in[18] + l * 31 * 512, ap->in[19] + l * 512, ap->in[20] + l * 512, ap->in[21] + l * 512,
                                  nullptr, out + O_CONFP + ((size_t)l * 8 + b) * 30 * 512, b * 2048, ti * 16, 2048, tid);
                } else if (u < 3200) { const int bs = u - 3072;
                    conf_unit<8>(lds, (const bf16*)(ws + WS_CA), (const bf16*)(ws + WS_CB), XCS, ap->in[18] + l * 31 * 512, ap->in[19] + l * 512, ap->in[20] + l * 512, ap->in[21] + l * 512,
                                 ap->in[5] + ((size_t)l * 128 + bs) * 30 * 512, out + O_CONFS + ((size_t)l * 128 + bs) * 30 * 512, NPROMPT + bs * 8, 0, 8, tid);
                } else {
                    sconv_unit((const bf16*)(ws + WS_SB), (const bf16*)(ws + WS_SCC), (const bf16*)(ws + WS_SX), XCS, ap->in[23] + l * 3 * 512, ap->in[6] + (size_t)l * 128 * 2 * 512,
                               out + O_SCP + (size_t)l * 8 * 2 * 512, out + O_SCS + (size_t)l * 128 * 2 * 512, u - 3200, tid);
                }
            }
        }
        GRID_BAR();
        {
            PHASE_BEGIN
            ret_scan((const float*)(ws + WS_KVB), (bf16*)(ws + WS_SCB), XW + O_RETP + (size_t)l * 64 * 8192, bid * NTHREADS + tid, G * NTHREADS);
            GEMM_PHASE(EpiBranch<0>, H, ws + WS_WCONF, MTOK, DM, 512, 1024, 512, (const bf16*)(ws + WS_GL), ap->in[15] + l * 3072, (float*)(ws + WS_M32), (bf16*)(ws + WS_MBF), 1) }
        GRID_BAR();
        {
            PHASE_BEGIN
            {   const bf16* Qb = (const bf16*)(ws + WS_Q); const bf16* Kb = (const bf16*)(ws + WS_K); const bf16* Vb = (const bf16*)(ws + WS_V); bf16* Gb = (bf16*)(ws + WS_G);
                const float* gn_g = ap->in[16] + l * 1024;
#pragma unroll 1
                for (int u = bid; u < 1024; u += G) { const int bh = u >> 4, c = u & 15;
                    ret_out_unit(lds, Qb, Kb, Vb, Gb, ROPE, gn_g, (const bf16*)(ws + WS_SCB) + (size_t)u * 8192, bh >> 3, bh & 7, c, tid); } }
            GEMM_PHASE(EpiBranch<1>, H + 512, ws + WS_WSC, MTOK, DM, 512, 1024, 512, (const bf16*)(ws + WS_GL), ap->in[15] + l * 3072, (float*)(ws + WS_M32), (bf16*)(ws + WS_MBF), 2) }
        GRID_BAR();
        {   PHASE_BEGIN
            GEMM_PHASE(EpiBranch<2>, ws + WS_G, ws + WS_WRET, MTOK, DM, 1024, 1024, 1024, (const bf16*)(ws + WS_GL), ap->in[15] + l * 3072, (float*)(ws + WS_M32), (bf16*)(ws + WS_MBF), 0) }
        GRID_BAR();
        {   PHASE_BEGIN
            const float* ada_l = ADA + (size_t)l * NSEQ * NADA;
#if PHASES & 4
            GEMM_PHASE(EpiResid, ws + WS_MBF, ws + WS_WO, MTOK, DM, 1024, 1024, 1024, XW, ada_l + 5 * 1024, 1.0f)
#endif
        }
        GRID_BAR();
        {   PHASE_BEGIN
            const float* ada_l = ADA + (size_t)l * NSEQ * NADA;
            rmsmod_phase(XW, XW + (size_t)NPROMPT * DM, nullptr, ap->in[26] + l * DM, ada_l, 6, H, gw, NGW, lane); }
        GRID_BAR();
        {   PHASE_BEGIN
#if PHASES & 2
            GEMM_PHASE(EpiSwiglu, H, ws + WS_W13B, MTOK, 2 * DFF, 1024, 1024, 1024, U)
#ifdef PROBE_UP
            GEMM_PHASE(EpiSwiglu, H, ws + WS_W13B, MTOK, 2 * DFF, 1024, 1024, 1024, U)
#endif
#endif
        }
        GRID_BAR();
        {   PHASE_BEGIN
            const float* ada_l = ADA + (size_t)l * NSEQ * NADA;
#if PHASES & 4
            GEMM_PHASE(EpiResid, U, ws + WS_W2B, MTOK, DM, DFF, DFF, DFF, XW, ada_l + 8 * 1024, 0.5f)
#endif
        }
        GRID_BAR();
    }
#ifdef PROBE_SYNC
#pragma unroll 1
    for (int q = 0; q < 32; ++q) GRID_BAR();
#endif
    {   PHASE_BEGIN
        final_norm_phase(XW, ap->in[30], gw, NGW, lane); }
}

extern "C" void kernel_launch(void* const* d_in, const int* in_sizes, int n_in, void* d_out, int out_size, void* d_ws, size_t ws_size, hipStream_t stream) {
    static int grid = 0;
    if (grid == 0) {
        if (n_in != 31 || out_size != (int)O_END || ws_size < WS_END) { fprintf(stderr, "kernel_launch: unexpected shapes (n_in %d, out %d, ws %zu)\n", n_in, out_size, ws_size); grid = -1; return; }
        int dev = 0, cus = 0, per_cu = 0;
        if (hipGetDevice(&dev) != hipSuccess || hipDeviceGetAttribute(&cus, hipDeviceAttributeMultiprocessorCount, dev) != hipSuccess) { grid = -1; return; }
        if (hipFuncSetAttribute((const void*)mega_fwd, hipFuncAttributeMaxDynamicSharedMemorySize, LDS_BYTES) != hipSuccess) { fprintf(stderr, "kernel_launch: hipFuncSetAttribute failed\n"); grid = -1; return; }
        if (hipOccupancyMaxActiveBlocksPerMultiprocessor(&per_cu, (const void*)mega_fwd, NTHREADS, LDS_BYTES) != hipSuccess || per_cu < 1) { fprintf(stderr, "kernel_launch: occupancy query failed (%d)\n", per_cu); (void)hipGetLastError(); grid = -1; return; }
        grid = cus * per_cu;
        if (grid < 128) { fprintf(stderr, "kernel_launch: grid %d too small\n", grid); grid = -1; return; }
    }
    if (grid < 0) return;
    Args a{};
    for (int i = 0; i < 31; ++i) a.in[i] = (const float*)d_in[i];
    a.out = (float*)d_out; a.ws = (unsigned char*)d_ws;
    if (hipMemsetAsync((char*)d_ws + WS_BAR, 0, WS_BAR_BYTES, stream) != hipSuccess) { fprintf(stderr, "kernel_launch: memset failed\n"); return; }
    void* args[] = {&a};
    hipError_t e = hipLaunchCooperativeKernel((const void*)mega_fwd, dim3(grid), dim3(NTHREADS), args, LDS_BYTES, stream);
    if (e != hipSuccess) fprintf(stderr, "kernel_launch: cooperative launch failed: %s (grid %d)\n", hipGetErrorString(e), grid);
}
```

```cpp
#include <hip/hip_runtime.h>
#include <hip/hip_cooperative_groups.h>
#include <cstdio>
#include <cstdint>
namespace cg = cooperative_groups;
namespace pg8 {
#define PG8_LAS __attribute__((address_space(3)))
typedef unsigned short bf16_t;
typedef short bf16x8 __attribute__((ext_vector_type(8)));
typedef float f32x4 __attribute__((ext_vector_type(4)));
typedef unsigned u32x4 __attribute__((ext_vector_type(4)));
constexpr int BM = 256, BK = 64, HALF = 128, HTB = HALF * BK * 2  , STAGE_BYTES = 8 * HTB, NXCD = 8, WGM = 8;

__host__ __device__ __forceinline__ int lds_byte(int r, int c) { const int st = (r >> 4) * 2 + (c >> 5), rr = r & 15, cc = c & 31, ob = rr * 64 + cc * 2; return st * 1024 + (ob ^ (((ob >> 9) & 1) << 5)); }
__host__ __device__ __forceinline__ void stage_rc(int b, int& R, int& C) { const int st = b / 1024, sb = b % 1024, swz = sb ^ (((sb >> 9) & 1) << 5); R = (st >> 1) * 16 + swz / 64; C = (st & 1) * 32 + (swz % 64) / 2; }
__host__ __device__ __forceinline__ int perm32(int rho) { const int n = rho >> 4, i = rho & 15; return 8 * (i >> 2) + 4 * n + (i & 3); }

struct Unit { int pm, pn, kb, nk, seg; };
struct Gemm { const bf16_t* A; const bf16_t* Bt; int M, N, K, lda, ldb; int tsw; long adelta; };

struct StaticOrder {
    int nM, nN, nwg, G, c, nt;
    __host__ __device__ __forceinline__ void init(int M, int N, int G_, int c_, int K) { nM = M / BM; nN = N / BM; nwg = nM * nN; G = G_; c = c_; nt = K / BK; }
    __host__ __device__ __forceinline__ void map(int wgid, int& pm, int& pn) const {
        { const int q = nwg / NXCD, r = nwg % NXCD, xcd = wgid % NXCD, off = wgid / NXCD; wgid = (xcd < r ? xcd * (q + 1) : r * (q + 1) + (xcd - r) * q) + off; }
        const int nig = WGM * nN, gid = wgid / nig, fm = gid * WGM, gsz = (nM - fm) < WGM ? (nM - fm) : WGM;
        pm = fm + ((wgid % nig) % gsz); pn = (wgid % nig) / gsz; }
    __host__ __device__ __forceinline__ bool next(int i, Unit& u) const {
        const long L = (long)i * G + c; const bool ok = L < nwg; int pm, pn; map(ok ? (int)L : 0, pm, pn);
        u.pm = pm; u.pn = pn; u.kb = 0; u.nk = nt; u.seg = 0; return ok; }
    __device__ __forceinline__ void a_ready(const Unit&) const {}
    __device__ __forceinline__ void done(const Unit&) const {}
};
struct ChainOrder {
    StaticOrder P; int pm0;
    __host__ __device__ __forceinline__ void init(int pm0_, int nMs, int N, int G_, int c_) { P.init(nMs * BM, N, G_, c_, 2048); pm0 = pm0_; }
    __host__ __device__ __forceinline__ bool next(int i, Unit& u) const {
        const int ti = i / 3, seg = i - 3 * ti; const long L = (long)ti * P.G + P.c; const bool ok = L < P.nwg && P.c >= 0; int pm, pn; P.map(ok ? (int)L : 0, pm, pn);
        u.pm = pm0 + pm; u.pn = pn; u.kb = seg * 8; u.nk = seg == 2 ? 16 : 8; u.seg = seg; return ok; }
    __device__ __forceinline__ void a_ready(const Unit&) const {}
    __device__ __forceinline__ void done(const Unit&) const {}
};
struct WinOrder {
    StaticOrder P;
    __host__ __device__ __forceinline__ void init(int M, int G_, int c_, int K) { P.init(M, 33 * BM, G_, c_, K); }
    __host__ __device__ __forceinline__ bool next(int i, Unit& u) const {
        const long L0 = (long)i * P.G + P.c; const bool isA = L0 < P.nwg; const long j = L0 - P.nwg; const bool isB = !isA && j < 60;
        int pm, pn; P.map(isA ? (int)L0 : 0, pm, pn); const int jb = isB ? (int)j : 0;
        u.pm = isA ? pm : (jb < 32 ? jb : jb + 8); u.pn = isA ? pn : 33; u.kb = 0; u.nk = P.nt; u.seg = 0; return isA || isB; }
    __device__ __forceinline__ void a_ready(const Unit&) const {}
    __device__ __forceinline__ void done(const Unit&) const {}
};
struct OneOrder {
    int pm, pn, nt;
    __host__ __device__ __forceinline__ bool next(int i, Unit& u) const { u.pm = pm; u.pn = pn; u.kb = 0; u.nk = nt; u.seg = 0; return i == 0; }
    __device__ __forceinline__ void a_ready(const Unit&) const {}
    __device__ __forceinline__ void done(const Unit&) const {}
};
struct SplitOrder {
    StaticOrder P; int S, nsub;
    __host__ __device__ __forceinline__ void init(int Mfull, int N, int G_, int c_, int K, int S_) { P.init(Mfull, N, G_, c_, K); S = S_; nsub = (P.nM - 64) * P.nN * S_; P.nM = 64; P.nwg = 64 * P.nN; }
    __host__ __device__ __forceinline__ bool next(int i, Unit& u) const {
        const bool special = (P.G == P.nwg) && (nsub <= P.G);
        const long L0 = (long)i * P.G + P.c; const bool hs = P.c < nsub;
        const bool isP = special ? (hs ? i == 1 : i == 0) : (L0 < P.nwg); const long Ls = special ? (long)P.c : L0 - P.nwg; const bool isS = special ? (hs && i == 0) : (!isP && Ls >= 0 && Ls < nsub);
        int ppm, ppn; P.map(isP ? (special ? P.c : (int)L0) : 0, ppm, ppn);
        const int L = isS ? (int)Ls : 0, tile = L / S, ks = L - tile * S, hp = P.nt / 2, q = hp / S, r = hp - q * S, spm = 64 + tile / P.nN, spn = tile - (tile / P.nN) * P.nN;
        const int skb = 2 * (ks * q + (ks < r ? ks : r)), snk = 2 * (q + (ks < r ? 1 : 0));
        u.pm = isP ? ppm : spm; u.pn = isP ? ppn : spn; u.nk = isP ? P.nt : snk; u.kb = isP ? 0 : skb; u.seg = isP ? 0 : ks; return isP || isS; }
    __device__ __forceinline__ void a_ready(const Unit&) const {}
    __device__ __forceinline__ void done(const Unit&) const {}
};


__device__ __forceinline__ unsigned cvt_pk_bf16(float lo, float hi) { unsigned r; asm volatile("v_cvt_pk_bf16_f32 %0, %1, %2" : "=v"(r) : "v"(lo), "v"(hi)); return r; }
typedef float f32x2 __attribute__((ext_vector_type(2)));

template <class Epi, class Sched, bool ALIGN_EPI = false, bool SP2 = false>
__device__ __forceinline__ void gemm_phase(PG8_LAS unsigned char* lds, const Gemm g, const Sched& S, const Epi& E) {
    int tid_ = threadIdx.x; asm volatile("" : "+v"(tid_)); const int tid = tid_, wid = __builtin_amdgcn_readfirstlane(tid >> 6), lane = tid & 63, wr = wid >> 2, wc = wid & 3, fr = lane & 15, fq = lane >> 4;
    unsigned voffA[2], voffB[2];
#pragma unroll
    for (int i = 0; i < 2; ++i) { int R, C; stage_rc(tid * 16 + i * 8192, R, C); const int Rb = Epi::PERM ? ((R & ~31) + perm32(R & 31)) : R;
        voffA[i] = (unsigned)(R * g.lda + C) * 2u; voffB[i] = (unsigned)(Rb * g.ldb + C) * 2u; }
    const size_t kstep = (size_t)(BK * 2);
    const size_t hstepA = (size_t)HALF * g.lda * 2, hstepB = (size_t)HALF * g.ldb * 2;
    const size_t tstepA = 2 * hstepA, tstepB = 2 * hstepB;
    const unsigned ldsw = (unsigned)wid * 1024u;
    const int aoff = lds_byte(wr * 64 + fr, fq * 8), boff = lds_byte(wc * 32 + fr, fq * 8);
#define PG8_SA(b, h) (((b) * 2 + (h)) * HTB)
#define PG8_SB(b, h) ((4 + (b) * 2 + (h)) * HTB)
#define PG8_STAGE(bufoff, gbase, voff) do { _Pragma("unroll") for (int _i = 0; _i < 2; ++_i) \
        __builtin_amdgcn_global_load_lds((const unsigned*)((const char*)(gbase) + (voff)[_i]), (PG8_LAS unsigned*)(lds + (bufoff) + ldsw + _i * 8192), 16, 0, 0); } while (0)
#define PG8_LDA(dst, b, h) do { _Pragma("unroll") for (int m = 0; m < 4; ++m) _Pragma("unroll") for (int k = 0; k < 2; ++k) dst[m][k] = *(const PG8_LAS bf16x8*)(lds + PG8_SA(b, h) + aoff + m * 2048 + k * 1024); } while (0)
#define PG8_LDB(dst, b, h) do { _Pragma("unroll") for (int n = 0; n < 2; ++n) _Pragma("unroll") for (int k = 0; k < 2; ++k) dst[n][k] = *(const PG8_LAS bf16x8*)(lds + PG8_SB(b, h) + boff + n * 2048 + k * 1024); } while (0)
#define PG8_MMA(ai, bj, At, Bt) do { __builtin_amdgcn_s_setprio(1); _Pragma("unroll") for (int m = 0; m < 4; ++m) _Pragma("unroll") for (int n = 0; n < 2; ++n) _Pragma("unroll") for (int k = 0; k < 2; ++k) \
        acc[ai][bj][m][n] = __builtin_amdgcn_mfma_f32_16x16x32_bf16(Bt[n][k], At[m][k], acc[ai][bj][m][n], 0, 0, 0); __builtin_amdgcn_s_setprio(0); } while (0)
#define PG8_WAIT_V(n) asm volatile("s_waitcnt vmcnt(" #n ")" ::: "memory")
#define PG8_WAIT_L(n) asm volatile("s_waitcnt lgkmcnt(" #n ")" ::: "memory")
#define PG8_BAR __builtin_amdgcn_s_barrier()
#define PG8_SCHED __builtin_amdgcn_sched_barrier(0)
    Unit cur, nxt; int ui = 0;
    if (!S.next(0, cur)) return;
    f32x4 acc[2][2][4][2];
    float zf_ = 0.f; asm volatile("" : "+v"(zf_));
#pragma unroll
    for (int a = 0; a < 2; ++a)
#pragma unroll
        for (int b = 0; b < 2; ++b)
#pragma unroll
            for (int m = 0; m < 4; ++m)
#pragma unroll
                for (int n = 0; n < 2; ++n) acc[a][b][m][n] = (f32x4){zf_, zf_, zf_, zf_};
    bf16x8 At[4][2], B0[2][2], B1[2][2];
    const int tsw = g.tsw; const long adelta = g.adelta;
    const char* cA = (const char*)g.A + (size_t)cur.pm * tstepA + (size_t)cur.kb * kstep + (cur.kb >= tsw ? adelta : 0l); const char* cB = (const char*)g.Bt + (size_t)cur.pn * tstepB + (size_t)cur.kb * kstep;
    S.a_ready(cur);
    if constexpr (SP2) {
        PG8_STAGE(PG8_SB(0, 0), cB, voffB); PG8_STAGE(PG8_SB(0, 1), cB + hstepB, voffB); PG8_STAGE(PG8_SA(0, 0), cA, voffA); PG8_STAGE(PG8_SA(0, 1), cA + hstepA, voffA);
        if (wr == 1) PG8_BAR;
        PG8_WAIT_V(2); PG8_BAR;
        PG8_STAGE(PG8_SB(1, 0), cB + kstep, voffB); PG8_STAGE(PG8_SA(1, 0), cA + kstep, voffA); PG8_STAGE(PG8_SB(1, 1), cB + hstepB + kstep, voffB);
        PG8_WAIT_V(6); PG8_BAR;
    } else {
        PG8_STAGE(PG8_SB(0, 0), cB, voffB); PG8_STAGE(PG8_SA(0, 0), cA, voffA); PG8_STAGE(PG8_SB(0, 1), cB + hstepB, voffB); PG8_STAGE(PG8_SA(0, 1), cA + hstepA, voffA);
        if (wr == 1) PG8_BAR;
        PG8_WAIT_V(4); PG8_BAR;
        PG8_STAGE(PG8_SB(1, 0), cB + kstep, voffB); PG8_STAGE(PG8_SA(1, 0), cA + kstep, voffA); PG8_STAGE(PG8_SB(1, 1), cB + hstepB + kstep, voffB);
        PG8_WAIT_V(6); PG8_BAR;
    }
    for (;;) {
        const bool has_next = S.next(ui + 1, nxt);
        const char* nA = has_next ? (const char*)g.A + (size_t)nxt.pm * tstepA + (size_t)nxt.kb * kstep + (nxt.kb >= tsw ? adelta : 0l) : cA; const char* nB = has_next ? (const char*)g.Bt + (size_t)nxt.pn * tstepB + (size_t)nxt.kb * kstep : cB;
        const int nt = cur.nk;
        for (int t = 0; t < nt; t += 2) {
            const bool last = (t == nt - 2);
            const char* a1 = cA + (size_t)(t + 1) * kstep;
            const char* a2 = last ? nA : cA + (size_t)(t + 2) * kstep; const char* b2 = last ? nB : cB + (size_t)(t + 2) * kstep;
            const char* a3 = a2 + kstep; const char* b3 = b2 + kstep;
            if (last && has_next) S.a_ready(nxt);
            if constexpr (SP2) {
            PG8_LDB(B0, 0, 0); PG8_LDB(B1, 0, 1); PG8_SCHED; PG8_LDA(At, 0, 0); PG8_STAGE(PG8_SA(1, 1), a1 + hstepA, voffA);
            PG8_WAIT_V(8); PG8_WAIT_L(0); PG8_BAR; PG8_MMA(0, 0, At, B0); PG8_MMA(0, 1, At, B1); PG8_BAR; PG8_SCHED;
            PG8_LDA(At, 0, 1); PG8_STAGE(PG8_SB(0, 0), b2, voffB); PG8_STAGE(PG8_SB(0, 1), b2 + hstepB, voffB); PG8_STAGE(PG8_SA(0, 0), a2, voffA);
            PG8_WAIT_V(8); PG8_WAIT_L(0); PG8_BAR; PG8_MMA(1, 0, At, B0); PG8_MMA(1, 1, At, B1); PG8_BAR; PG8_SCHED;
            PG8_LDB(B0, 1, 0); PG8_LDB(B1, 1, 1); PG8_SCHED; PG8_LDA(At, 1, 0); PG8_STAGE(PG8_SA(0, 1), a2 + hstepA, voffA);
            PG8_WAIT_V(8); PG8_WAIT_L(0); PG8_BAR; PG8_MMA(0, 0, At, B0); PG8_MMA(0, 1, At, B1); PG8_BAR; PG8_SCHED;
            PG8_LDA(At, 1, 1); PG8_STAGE(PG8_SB(1, 0), b3, voffB); PG8_STAGE(PG8_SB(1, 1), b3 + hstepB, voffB); PG8_STAGE(PG8_SA(1, 0), a3, voffA);
            PG8_WAIT_V(8); PG8_WAIT_L(0); PG8_BAR; PG8_MMA(1, 0, At, B0); PG8_MMA(1, 1, At, B1); PG8_BAR; PG8_SCHED;
            } else {
            PG8_LDB(B0, 0, 0); PG8_SCHED; PG8_LDA(At, 0, 0); PG8_STAGE(PG8_SA(1, 1), a1 + hstepA, voffA);
            PG8_WAIT_L(8); PG8_BAR; PG8_WAIT_L(0); PG8_MMA(0, 0, At, B0); PG8_BAR; PG8_SCHED;
            PG8_LDB(B1, 0, 1); PG8_STAGE(PG8_SB(0, 0), b2, voffB);
            PG8_BAR; PG8_WAIT_L(0); PG8_MMA(0, 1, At, B1); PG8_BAR;
            PG8_LDA(At, 0, 1); PG8_STAGE(PG8_SA(0, 0), a2, voffA);
            PG8_BAR; PG8_WAIT_L(0); PG8_MMA(1, 0, At, B0); PG8_BAR; PG8_SCHED;
            PG8_STAGE(PG8_SB(0, 1), b2 + hstepB, voffB);
            PG8_WAIT_V(6); PG8_BAR; PG8_MMA(1, 1, At, B1); PG8_BAR;
            PG8_LDB(B0, 1, 0); PG8_SCHED; PG8_LDA(At, 1, 0); PG8_STAGE(PG8_SA(0, 1), a2 + hstepA, voffA);
            PG8_WAIT_L(8); PG8_BAR; PG8_WAIT_L(0); PG8_MMA(0, 0, At, B0); PG8_BAR; PG8_SCHED;
            PG8_LDB(B1, 1, 1); PG8_STAGE(PG8_SB(1, 0), b3, voffB);
            PG8_BAR; PG8_WAIT_L(0); PG8_MMA(0, 1, At, B1); PG8_BAR;
            PG8_LDA(At, 1, 1); PG8_STAGE(PG8_SA(1, 0), a3, voffA);
            PG8_BAR; PG8_WAIT_L(0); PG8_MMA(1, 0, At, B0); PG8_BAR; PG8_SCHED;
            PG8_STAGE(PG8_SB(1, 1), b3 + hstepB, voffB);
            PG8_WAIT_V(6); PG8_BAR; PG8_MMA(1, 1, At, B1); PG8_BAR;
            }
        }
        if constexpr (ALIGN_EPI) { if (wr == 0) PG8_BAR; }
        if constexpr (!Epi::AFTER_DRAIN) { E(acc, cur, wr, wc, fr, fq); S.done(cur); }
        if (!has_next) break;
        if (!(Epi::CHAIN && cur.seg < 2)) {
#pragma unroll
        for (int a = 0; a < 2; ++a)
#pragma unroll
            for (int b = 0; b < 2; ++b)
#pragma unroll
                for (int m = 0; m < 4; ++m)
#pragma unroll
                    for (int n = 0; n < 2; ++n) acc[a][b][m][n] = (f32x4){0.f, 0.f, 0.f, 0.f};
        }
        cur = nxt; cA = nA; cB = nB; ++ui;
        if constexpr (ALIGN_EPI) { if (wr == 1) PG8_BAR; }
    }
    PG8_WAIT_V(0);
    if constexpr (!ALIGN_EPI) { if (wr == 0) PG8_BAR; }
    PG8_BAR;
    if constexpr (Epi::AFTER_DRAIN) { E.fused(acc, cur, wr, wc, fr, fq, lds, wid, lane); S.done(cur); }
#undef PG8_SA
#undef PG8_SB
#undef PG8_STAGE
#undef PG8_LDA
#undef PG8_LDB
#undef PG8_MMA
#undef PG8_WAIT_V
#undef PG8_WAIT_L
#undef PG8_BAR
#undef PG8_SCHED
}
}
#ifndef PHASES
#define PHASES 0xFFFF
#endif

#define LAS __attribute__((address_space(3)))
typedef unsigned short bf16;
typedef float f32x4 __attribute__((ext_vector_type(4)));
typedef short bf16x8 __attribute__((ext_vector_type(8)));
typedef unsigned u32x4 __attribute__((ext_vector_type(4)));
typedef unsigned u32x2 __attribute__((ext_vector_type(2)));

constexpr int NPROMPT = 8 * 2048, NSAMPLE = 128 * 8, MTOK = NPROMPT + NSAMPLE;
constexpr int DM = 1024, DFF = 2816, NADA = 9216, NSEQ = 136, INCOLS = 8704;
constexpr int NTHREADS = 512, NWAVES = 8;

constexpr size_t MiB = 1u << 20;
constexpr size_t WS_ADA = 0, WS_CSIL = 10 * MiB, WS_ROPE = 11 * MiB;
constexpr size_t WS_W13A = 12 * MiB, WS_W2A = 23 * MiB, WS_W13B = 29 * MiB, WS_W2B = 40 * MiB, WS_WIN = 46 * MiB;
constexpr size_t WS_WBR = 63 * MiB, WS_WO = 67 * MiB;
constexpr size_t WS_H = 69 * MiB;
constexpr size_t WS_Z = 103 * MiB;
constexpr size_t WS_Q = WS_Z, WS_K = WS_Z + 17 * MiB, WS_V = WS_Z + 34 * MiB, WS_G = WS_Z + 68 * MiB;
constexpr size_t WS_CA = WS_Z + 102 * MiB, WS_CB = WS_Z + 119 * MiB, WS_SB = WS_Z + 136 * MiB, WS_SCC = WS_Z + 153 * MiB, WS_SX = WS_Z + 170 * MiB;
constexpr size_t WS_GL = WS_Z + 187 * MiB;
constexpr size_t WS_KVB = WS_GL + 102 * MiB;
constexpr size_t WS_BAR = WS_KVB + 32 * MiB;
constexpr size_t WS_BAR_BYTES = 65536;
constexpr size_t WS_END = WS_BAR + WS_BAR_BYTES;
constexpr size_t WS_SCB = WS_SX;
constexpr size_t WS_U = WS_Z;
constexpr size_t WS_WADA = WS_Z;
constexpr size_t WS_M32 = WS_CA;
constexpr size_t WS_MBF = WS_V;

constexpr size_t O_Y = 0, O_RETP = 17825792, O_RETS = 18874368, O_CONFP = 35651584, O_CONFS = 35897344, O_SCP = 39829504, O_SCS = 39845888, O_END = 40108032;

constexpr int LDS_BYTES = 147456;

__device__ __forceinline__ unsigned f2bf(float f) { unsigned u = __builtin_bit_cast(unsigned, f); return (u + 0x7fffu + ((u >> 16) & 1u)) >> 16; }
__device__ __forceinline__ unsigned pk2(float lo, float hi) { return f2bf(lo) | (f2bf(hi) << 16); }
__device__ __forceinline__ float bf2f(unsigned b) { return __builtin_bit_cast(float, b << 16); }
__device__ __forceinline__ float bflo(unsigned w) { return __builtin_bit_cast(float, w << 16); }
__device__ __forceinline__ float bfhi(unsigned w) { return __builtin_bit_cast(float, w & 0xffff0000u); }
__device__ __forceinline__ float sigmoidf_(float x) { return __builtin_amdgcn_rcpf(1.0f + __expf(-x)); }
__device__ __forceinline__ float siluf_(float x) { return x * sigmoidf_(x); }
__device__ __forceinline__ int seq_of_row(int row) { return row < NPROMPT ? (row >> 11) : 8 + ((row - NPROMPT) >> 3); }
__device__ __forceinline__ float wave_sum(float v) {
#pragma unroll
    for (int o = 1; o < 64; o <<= 1) v += __shfl_xor(v, o);
    return v;
}
__device__ __forceinline__ float lgamma_h(int h) {
    float r = -0.0317486983145803f;
    r = h == 1 ? -0.015748356968139168f : r; r = h == 2 ? -0.007843177461025893f : r; r = h == 3 ? -0.003913899321136329f : r;
    r = h == 4 ? -0.0019550348358033506f : r; r = h == 5 ? -0.0009770396478266127f : r; r = h == 6 ? -0.0004884004981088745f : r; r = h == 7 ? -0.0002441704321739145f : r;
    return r;
}

using pg8::Unit;
struct EpiSwiglu {
    static constexpr bool PERM = true, AFTER_DRAIN = false, CHAIN = false;
    bf16* U;
    __device__ __forceinline__ void operator()(const f32x4 (&acc)[2][2][4][2], const Unit& u, int wr, int wc, int fr, int fq) const {
        const int row0 = u.pm * 256 + wr * 64 + fr, ucol0 = u.pn * 128 + wc * 16 + 4 * fq;
#pragma unroll
        for (int ai = 0; ai < 2; ++ai)
#pragma unroll
            for (int m = 0; m < 4; ++m) { bf16* rowp = U + (size_t)(row0 + ai * 128 + m * 16) * DFF + ucol0;
#pragma unroll
                for (int bj = 0; bj < 2; ++bj) { const f32x4 v0 = acc[ai][bj][m][0], v1 = acc[ai][bj][m][1];
                    u32x2 w; w.x = pk2(siluf_(v0[0]) * v1[0], siluf_(v0[1]) * v1[1]); w.y = pk2(siluf_(v0[2]) * v1[2], siluf_(v0[3]) * v1[3]);
                    *(u32x2*)(rowp + bj * 64) = w; } }
    }
};
struct EpiResid {
    static constexpr bool PERM = false, AFTER_DRAIN = false, CHAIN = false;
    float* x; float* wsf; int goff; float coef; int nt_full;
    __device__ __forceinline__ void operator()(const f32x4 (&acc)[2][2][4][2], const Unit& u, int wr, int wc, int fr, int fq) const {
        const int col0 = u.pn * 256 + wc * 32 + 4 * fq; const bool part = u.nk != nt_full; const int ksub = u.seg;
#pragma unroll
        for (int ai = 0; ai < 2; ++ai)
#pragma unroll
            for (int m = 0; m < 4; ++m) { const int row = u.pm * 256 + ai * 128 + wr * 64 + m * 16 + fr; const float* gp = wsf + goff + (size_t)seq_of_row(row) * NADA + col0; float* xp = x + (size_t)row * DM + col0;
#pragma unroll
                for (int bj = 0; bj < 2; ++bj)
#pragma unroll
                    for (int n = 0; n < 2; ++n) { const int c = bj * 128 + n * 16; const f32x4 g4 = *(const f32x4*)(gp + c); const f32x4 v = acc[ai][bj][m][n] * g4 * coef;
                        if (part) { *(f32x4*)(wsf + WS_KVB / 4 + ((size_t)ksub * NSAMPLE + (row - NPROMPT)) * DM + col0 + c) = v; }
                        else { const f32x4 xv = *(const f32x4*)(xp + c); *(f32x4*)(xp + c) = xv + v; } }
                if (m & 1) asm volatile("" ::: "memory"); }
    }
};
struct EpiBranch3 {
    static constexpr bool PERM = false, AFTER_DRAIN = false, CHAIN = true;
    const bf16* GL; const float* bgate; bf16* MBF;
    __device__ __forceinline__ void operator()(f32x4 (&acc)[2][2][4][2], const Unit& u, int wr, int wc, int fr, int fq) const {
        const int col0 = u.pn * 256 + wc * 32 + 4 * fq; const int seg = u.seg;
        const int ba = seg == 0 ? 1024 : (seg == 1 ? 2048 : 0), bb = seg == 0 ? 2048 : 0; const float fb = seg == 2 ? 0.f : 1.f;
#pragma unroll
        for (int ai = 0; ai < 2; ++ai)
#pragma unroll
            for (int m = 0; m < 4; ++m) { const int row = u.pm * 256 + ai * 128 + wr * 64 + m * 16 + fr; const bf16* gl = GL + (size_t)row * 3072;
#pragma unroll
                for (int bj = 0; bj < 2; ++bj)
#pragma unroll
                    for (int n = 0; n < 2; ++n) { const int c = col0 + bj * 128 + n * 16;
                        const u32x2 wa = *(const u32x2*)(gl + ba + c), wb = *(const u32x2*)(gl + bb + c); const f32x4 za = *(const f32x4*)(bgate + ba + c), zb = *(const f32x4*)(bgate + bb + c);
                        f32x4 r;
                        r[0] = (1.0f + fb * __expf(-(bflo(wb.x) + zb[0]))) * __builtin_amdgcn_rcpf(1.0f + __expf(-(bflo(wa.x) + za[0])));
                        r[1] = (1.0f + fb * __expf(-(bfhi(wb.x) + zb[1]))) * __builtin_amdgcn_rcpf(1.0f + __expf(-(bfhi(wa.x) + za[1])));
                        r[2] = (1.0f + fb * __expf(-(bflo(wb.y) + zb[2]))) * __builtin_amdgcn_rcpf(1.0f + __expf(-(bflo(wa.y) + za[2])));
                        r[3] = (1.0f + fb * __expf(-(bfhi(wb.y) + zb[3]))) * __builtin_amdgcn_rcpf(1.0f + __expf(-(bfhi(wa.y) + za[3])));
                        const f32x4 v = acc[ai][bj][m][n] * r; acc[ai][bj][m][n] = v;
                        if (seg == 2) { u32x2 w; w.x = pk2(v[0], v[1]); w.y = pk2(v[2], v[3]); *(u32x2*)(MBF + (size_t)row * DM + c) = w; }
                        asm volatile("" ::: "memory"); } }
    }
};
struct EpiWin {
    static constexpr bool PERM = true, AFTER_DRAIN = false, CHAIN = false;
    unsigned char* ws;
    __device__ __forceinline__ void operator()(const f32x4 (&acc)[2][2][4][2], const Unit& u, int wr, int wc, int fr, int fq) const {
        const int colt = u.pn * 256; size_t off; int ld, c0, kind = 0;
        if (colt < 512) { off = WS_Q; ld = 512; c0 = colt; }
        else if (colt < 1024) { off = WS_K; ld = 512; c0 = colt - 512; }
        else if (colt < 2048) { off = WS_V; ld = 1024; c0 = colt - 1024; }
        else if (colt < 3072) { off = WS_G; ld = 1024; c0 = colt - 2048; }
        else if (colt < 4096) { off = WS_CA; ld = 512; c0 = (colt - 3072) >> 1; kind = 1; }
        else if (colt < 4608) { off = WS_SB; ld = 512; c0 = colt - 4096; }
        else if (colt < 5632) { off = WS_SCC; ld = 512; c0 = (colt - 4608) >> 1; kind = 2; }
        else { off = WS_GL; ld = 3072; c0 = colt - 5632; }
        bf16* base = (bf16*)(ws + off);
        const int row0 = u.pm * 256 + wr * 64 + fr;
        if (kind == 0) {
            const int col0 = c0 + wc * 32 + 8 * fq;
#pragma unroll
            for (int ai = 0; ai < 2; ++ai)
#pragma unroll
                for (int m = 0; m < 4; ++m) { bf16* rowp = base + (size_t)(row0 + ai * 128 + m * 16) * ld + col0;
#pragma unroll
                    for (int bj = 0; bj < 2; ++bj) { const f32x4 v0 = acc[ai][bj][m][0], v1 = acc[ai][bj][m][1];
                        u32x4 w; w.x = pk2(v0[0], v0[1]); w.y = pk2(v0[2], v0[3]); w.z = pk2(v1[0], v1[1]); w.w = pk2(v1[2], v1[3]);
                        *(u32x4*)(rowp + bj * 128) = w; } }
        } else {
            const int col0 = c0 + wc * 16 + 4 * fq;
#pragma unroll
            for (int ai = 0; ai < 2; ++ai)
#pragma unroll
                for (int m = 0; m < 4; ++m) { bf16* rowp = base + (size_t)(row0 + ai * 128 + m * 16) * ld + col0;
#pragma unroll
                    for (int bj = 0; bj < 2; ++bj) { const f32x4 v0 = acc[ai][bj][m][0], v1 = acc[ai][bj][m][1];
                        f32x4 o;
                        if (kind == 1) { o[0] = v0[0] * sigmoidf_(v1[0]); o[1] = v0[1] * sigmoidf_(v1[1]); o[2] = v0[2] * sigmoidf_(v1[2]); o[3] = v0[3] * sigmoidf_(v1[3]); }
                        else o = v0 * v1;
                        u32x2 w; w.x = pk2(o[0], o[1]); w.y = pk2(o[2], o[3]); *(u32x2*)(rowp + bj * 64) = w; } }
        }
    }
};
struct EpiAda {
    static constexpr bool PERM = false, AFTER_DRAIN = false, CHAIN = false;
    float* ADA; const float* bada;
    __device__ __forceinline__ void operator()(const f32x4 (&acc)[2][2][4][2], const Unit& u, int wr, int wc, int fr, int fq) const {
        const int l = u.pn / 36, col0 = (u.pn - l * 36) * 256 + wc * 32 + 4 * fq;
#pragma unroll
        for (int ai = 0; ai < 2; ++ai)
#pragma unroll
            for (int m = 0; m < 4; ++m) { const int row = ai * 128 + wr * 64 + m * 16 + fr;
                if (row < NSEQ) {
#pragma unroll
                    for (int bj = 0; bj < 2; ++bj)
#pragma unroll
                        for (int n = 0; n < 2; ++n) { const int c = col0 + bj * 128 + n * 16;
                            *(f32x4*)(ADA + ((size_t)l * NSEQ + row) * NADA + c) = acc[ai][bj][m][n] + *(const f32x4*)(bada + (size_t)l * NADA + c); } } }
    }
};

struct ConvD { const float* W; bf16* WT; int N, ldk, mode, roff, r; };
__device__ __forceinline__ void conv_load(float (&v)[32], const ConvD& d, int lane) {
    const int nblk = d.N / 32, kb = d.r / nblk, nb = d.r - kb * nblk; const float* p = d.W + (size_t)(64 * kb + (lane >> 5)) * d.N + 32 * nb + (lane & 31);
#pragma unroll
    for (int i = 0; i < 32; ++i) v[i] = p[(size_t)(2 * i) * d.N];
}
__device__ __forceinline__ void conv_store(const float (&v)[32], const ConvD& d, LAS float* scr, int lane) {
    const int nblk = d.N / 32, kb = d.r / nblk, nb = d.r - kb * nblk, k0 = 64 * kb, n0 = 32 * nb;
#pragma unroll
    for (int i = 0; i < 32; ++i) scr[(2 * i + (lane >> 5)) * 33 + (lane & 31)] = v[i];
    asm volatile("s_waitcnt lgkmcnt(0)" ::: "memory");
    const int c = lane & 7;
#pragma unroll
    for (int j = 0; j < 4; ++j) { const int n = (lane >> 3) + 8 * j; const LAS float* s = scr + (8 * c) * 33 + n; const int ng = n0 + n;
        int row = d.mode == 0 ? d.roff + ng : (((ng >> 2) << 3) + (d.mode == 2 ? 4 : 0) + (ng & 3));
        if (d.mode == 3) { row = ng; const int base = (ng >= 3072 && ng < 4096) ? 3072 : ((ng >= 4608 && ng < 5632) ? 4608 : -1);
            if (base >= 0) { const int loc = ng - base; row = base + (((loc & 511) >> 2) << 3) + ((loc >> 9) << 2) + (loc & 3); } }
        u32x4 o; o.x = pk2(s[0 * 33], s[1 * 33]); o.y = pk2(s[2 * 33], s[3 * 33]); o.z = pk2(s[4 * 33], s[5 * 33]); o.w = pk2(s[6 * 33], s[7 * 33]);
        *(u32x4*)(d.WT + (size_t)row * d.ldk + k0 + 8 * c) = o; }
    asm volatile("s_waitcnt lgkmcnt(0)" ::: "memory");
}

struct Args { const float* in[31]; float* out; unsigned char* ws; };
typedef const __attribute__((address_space(4))) Args* ArgsP;

#define CDESC(Wp, Kk, Nn, WTp, ldk_, mode_, roff_) { const int cnt_ = ((Kk) / 64) * ((Nn) / 32); if (r < cnt_) { d.W = (Wp); d.WT = (WTp); d.N = (Nn); d.ldk = (ldk_); d.mode = (mode_); d.roff = (roff_); d.r = r; return d; } r -= cnt_; }
constexpr int LAYER_CONV_MAIN = 5 * 1408 + 4352 + 512 + 256 + 256 + 512;
__device__ __forceinline__ ConvD conv_desc_main(ArgsP ap, unsigned char* ws, int l, int it) {
    ConvD d; int r = it; const size_t ffo = (size_t)l * DM * DFF;
    CDESC(ap->in[10] + ffo, 1024, 2816, (bf16*)(ws + WS_W13A), 1024, 1, 0)
    CDESC(ap->in[11] + ffo, 1024, 2816, (bf16*)(ws + WS_W13A), 1024, 2, 0)
    CDESC(ap->in[12] + ffo, 2816, 1024, (bf16*)(ws + WS_W2A), 2816, 0, 0)
    CDESC(ap->in[27] + ffo, 1024, 2816, (bf16*)(ws + WS_W13B), 1024, 1, 0)
    CDESC(ap->in[28] + ffo, 1024, 2816, (bf16*)(ws + WS_W13B), 1024, 2, 0)
    CDESC(ap->in[14] + (size_t)l * DM * INCOLS, 1024, 8704, (bf16*)(ws + WS_WIN), 1024, 3, 0)
    CDESC(ap->in[17] + (size_t)l * 1024 * 1024, 1024, 1024, (bf16*)(ws + WS_WBR) + 1024, 2048, 0, 0)
    CDESC(ap->in[22] + (size_t)l * 512 * 1024, 512, 1024, (bf16*)(ws + WS_WBR), 2048, 0, 0)
    CDESC(ap->in[24] + (size_t)l * 512 * 1024, 512, 1024, (bf16*)(ws + WS_WBR) + 512, 2048, 0, 0)
    d.W = ap->in[25] + (size_t)l * 1024 * 1024; d.WT = (bf16*)(ws + WS_WO); d.N = 1024; d.ldk = 1024; d.mode = 0; d.roff = 0; d.r = r; return d;
}
__device__ __forceinline__ ConvD conv_desc_w2b(ArgsP ap, unsigned char* ws, int l, int it) {
    ConvD d; d.W = ap->in[29] + (size_t)l * DM * DFF; d.WT = (bf16*)(ws + WS_W2B); d.N = 1024; d.ldk = 2816; d.mode = 0; d.roff = 0; d.r = it; return d; }
__device__ __forceinline__ ConvD conv_desc_ada(ArgsP ap, unsigned char* ws, int l_unused, int it) {
    const int l = it / 4608; ConvD d; d.W = ap->in[7] + (size_t)l * DM * NADA; d.WT = (bf16*)(ws + WS_WADA); d.N = NADA; d.ldk = 1024; d.mode = 0; d.roff = l * NADA; d.r = it - l * 4608; return d; }
#define CONV_LOOP(DESC, total) do { LAS float* scr = (LAS float*)(lds + wave * 16384); int it = gw; if (it < (total)) { float va[32], vb[32]; ConvD da = DESC(ap, ws, l, it), db = da; conv_load(va, da, lane); \
        for (;;) { const int i1_ = it + NGW; const bool h1_ = i1_ < (total); if (h1_) { db = DESC(ap, ws, l, i1_); conv_load(vb, db, lane); } conv_store(va, da, scr, lane); if (!h1_) break; \
                   const int i2_ = i1_ + NGW; const bool h2_ = i2_ < (total); if (h2_) { da = DESC(ap, ws, l, i2_); conv_load(va, da, lane); } conv_store(vb, db, scr, lane); if (!h2_) break; it = i2_; } } } while (0)
__device__ __forceinline__ void convert_layer_main(ArgsP ap, unsigned char* ws, int l, LAS unsigned char* lds, int gw, int NGW, int wave, int lane) { CONV_LOOP(conv_desc_main, LAYER_CONV_MAIN); }
__device__ __forceinline__ void convert_layer_w2b(ArgsP ap, unsigned char* ws, int l, LAS unsigned char* lds, int gw, int NGW, int wave, int lane) { CONV_LOOP(conv_desc_w2b, 1408); }
__device__ __forceinline__ void convert_ada_weights(ArgsP ap, unsigned char* ws, LAS unsigned char* lds, int gw, int NGW, int wave, int lane) { const int l = 0; CONV_LOOP(conv_desc_ada, 2 * 4608); }

__device__ __forceinline__ void rms_row_load(f32x4 (&v)[4], const float* xrow, int m, const float* P, int nP, int lane) {
    const f32x4* xr = (const f32x4*)xrow + lane;
#pragma unroll
    for (int j = 0; j < 4; ++j) v[j] = xr[64 * j];
    if (nP > 0 && m >= NPROMPT) {
        for (int q = 0; q < nP; ++q) { const f32x4* pr = (const f32x4*)(P + ((size_t)q * NSAMPLE + (m - NPROMPT)) * DM) + lane;
#pragma unroll
            for (int j = 0; j < 4; ++j) v[j] = v[j] + pr[64 * j]; }
        f32x4* xw = (f32x4*)(const_cast<float*>(xrow)) + lane;
#pragma unroll
        for (int j = 0; j < 4; ++j) xw[64 * j] = v[j]; }
}
__device__ __forceinline__ void rms_row_finish(const f32x4 (&v)[4], int m, float* xcopy, const float* gnorm, const float* ada_l, int sidx, bf16* H, int lane) {
    const float* sh = ada_l + (size_t)seq_of_row(m) * NADA + sidx * 1024; const float* sc = sh + 1024;
    f32x4 g4[4], s4[4], c4[4];
#pragma unroll
    for (int j = 0; j < 4; ++j) { const int c = 4 * (lane + 64 * j); g4[j] = *(const f32x4*)(gnorm + c); s4[j] = *(const f32x4*)(sh + c); c4[j] = *(const f32x4*)(sc + c); }
    float s = 0.f;
#pragma unroll
    for (int j = 0; j < 4; ++j) s += (v[j][0] * v[j][0] + v[j][1] * v[j][1]) + (v[j][2] * v[j][2] + v[j][3] * v[j][3]);
    const float rstd = 1.0f / sqrtf(wave_sum(s) * (1.f / DM) + 1e-6f);
    if (xcopy) { f32x4* xc = (f32x4*)(xcopy + (size_t)m * DM) + lane;
#pragma unroll
        for (int j = 0; j < 4; ++j) xc[64 * j] = v[j]; }
    u32x2* o8 = (u32x2*)(H + (size_t)m * DM) + lane;
#pragma unroll
    for (int j = 0; j < 4; ++j) { const f32x4 o = v[j] * rstd * g4[j] * (c4[j] + 1.0f) + s4[j];
        u32x2 w; w.x = pk2(o[0], o[1]); w.y = pk2(o[2], o[3]); o8[64 * j] = w; }
}
#define RMS_XROW(mm) ((mm) < NPROMPT ? xp + (size_t)(mm) * DM : xs + (size_t)((mm) - NPROMPT) * DM)
__device__ __forceinline__ void rmsmod_phase(const float* xp, const float* xs, float* xcopy, const float* gnorm, const float* ada_l, int sidx, bf16* H, const float* P, int nP, int gw, int NGW, int lane) {
    int m = gw; if (m >= MTOK) return;
    f32x4 a[4], b[4], c[4];
    rms_row_load(a, RMS_XROW(m), m, P, nP, lane);
    if (m + NGW < MTOK) rms_row_load(b, RMS_XROW(m + NGW), m + NGW, P, nP, lane);
    for (;;) {
        if (m + 2 * NGW < MTOK) rms_row_load(c, RMS_XROW(m + 2 * NGW), m + 2 * NGW, P, nP, lane);
        rms_row_finish(a, m, xcopy, gnorm, ada_l, sidx, H, lane);
        m += NGW; if (m >= MTOK) break;
        if (m + 2 * NGW < MTOK) rms_row_load(a, RMS_XROW(m + 2 * NGW), m + 2 * NGW, P, nP, lane);
        rms_row_finish(b, m, xcopy, gnorm, ada_l, sidx, H, lane);
        m += NGW; if (m >= MTOK) break;
        if (m + 2 * NGW < MTOK) rms_row_load(b, RMS_XROW(m + 2 * NGW), m + 2 * NGW, P, nP, lane);
        rms_row_finish(c, m, xcopy, gnorm, ada_l, sidx, H, lane);
        m += NGW; if (m >= MTOK) break;
    }
}
__device__ __forceinline__ void final_row_finish(const f32x4 (&v)[4], float* x, const float* g, int m, int lane) {
    f32x4 g4[4];
#pragma unroll
    for (int j = 0; j < 4; ++j) g4[j] = *(const f32x4*)(g + 4 * (lane + 64 * j));
    float s = 0.f;
#pragma unroll
    for (int j = 0; j < 4; ++j) s += (v[j][0] * v[j][0] + v[j][1] * v[j][1]) + (v[j][2] * v[j][2] + v[j][3] * v[j][3]);
    const float rstd = 1.0f / sqrtf(wave_sum(s) * (1.f / DM) + 1e-6f);
    f32x4* xr = (f32x4*)(x + (size_t)m * DM) + lane;
#pragma unroll
    for (int j = 0; j < 4; ++j) xr[64 * j] = v[j] * rstd * g4[j];
}
__device__ __forceinline__ void final_norm_phase(float* x, const float* g, const float* P, int nP, int gw, int NGW, int lane) {
    int m = gw; if (m >= MTOK) return;
    f32x4 a[4], b[4];
    rms_row_load(a, x + (size_t)m * DM, m, P, nP, lane);
    for (;;) {
        const int mn = m + NGW; const bool has = mn < MTOK;
        if (has) rms_row_load(b, x + (size_t)mn * DM, mn, P, nP, lane);
        final_row_finish(a, x, g, m, lane);
        if (!has) break;
        const int mn2 = mn + NGW; const bool has2 = mn2 < MTOK;
        if (has2) rms_row_load(a, x + (size_t)mn2 * DM, mn2, P, nP, lane);
        final_row_finish(b, x, g, mn, lane);
        if (!has2) break;
        m = mn2;
    }
}

#define MFMA16(a, b, c) __builtin_amdgcn_mfma_f32_16x16x32_bf16((a), (b), (c), 0, 0, 0)
typedef short s16x4 __attribute__((ext_vector_type(4)));
__device__ __forceinline__ s16x4 trread(const LAS unsigned char* p) { return __builtin_amdgcn_ds_read_tr16_b64_v4i16((LAS s16x4*)p); }
__device__ __forceinline__ s16x4 ld8(const LAS unsigned char* p) { return *(const LAS s16x4*)p; }
__device__ __forceinline__ bf16x8 cat8(s16x4 a, s16x4 b) { return (bf16x8){a[0], a[1], a[2], a[3], b[0], b[1], b[2], b[3]}; }
constexpr int ST64 = 144, ST128 = 288, STY = 272;
constexpr int L2_QS = 0, L2_KS = 18432, L2_VS = 36864, L2_SS = 73728, L2_YS = 92160;

template <bool WITH_Q> __device__ __forceinline__ void ret_load_chunk(LAS unsigned char* lds, const bf16* Q, const bf16* K, const bf16* V, const float* rope, int row0, int pos0, int h, float lg, int tid) {
    const int i = tid >> 2, gq = tid & 3; const size_t rb = (size_t)(row0 + i) * 512 + h * 64 + 8 * gq;
    const u32x4 klo = *(const u32x4*)(K + rb), khi = *(const u32x4*)(K + rb + 32);
    u32x4 qlo = klo, qhi = khi; if (WITH_Q) { qlo = *(const u32x4*)(Q + rb); qhi = *(const u32x4*)(Q + rb + 32); }
    const f32x4* rp = (const f32x4*)(rope + ((size_t)(pos0 + i) * 32 + 8 * gq) * 2);
    const f32x4 r0 = rp[0], r1 = rp[1], r2 = rp[2], r3 = rp[3];
    u32x4 vv[4];
#pragma unroll
    for (int y = 0; y < 4; ++y) vv[y] = *(const u32x4*)(V + (size_t)(row0 + i) * 1024 + h * 128 + 32 * gq + 8 * y);
    const float cs[8] = {r0[0], r0[2], r1[0], r1[2], r2[0], r2[2], r3[0], r3[2]}, sn[8] = {r0[1], r0[3], r1[1], r1[3], r2[1], r2[3], r3[1], r3[3]};
    const unsigned ql[4] = {qlo.x, qlo.y, qlo.z, qlo.w}, qh[4] = {qhi.x, qhi.y, qhi.z, qhi.w}, kl[4] = {klo.x, klo.y, klo.z, klo.w}, kh[4] = {khi.x, khi.y, khi.z, khi.w};
    const float gi = __expf((float)i * lg) * 0.125f, gk = __expf(-(float)i * lg);
    float qa[8], qb[8], ka[8], kb[8];
#pragma unroll
    for (int x = 0; x < 8; ++x) {
        const float k1 = (x & 1) ? bfhi(kl[x >> 1]) : bflo(kl[x >> 1]), k2 = (x & 1) ? bfhi(kh[x >> 1]) : bflo(kh[x >> 1]);
        ka[x] = (k1 * cs[x] - k2 * sn[x]) * gk; kb[x] = (k1 * sn[x] + k2 * cs[x]) * gk;
        if (WITH_Q) { const float q1 = (x & 1) ? bfhi(ql[x >> 1]) : bflo(ql[x >> 1]), q2 = (x & 1) ? bfhi(qh[x >> 1]) : bflo(qh[x >> 1]);
            qa[x] = (q1 * cs[x] - q2 * sn[x]) * gi; qb[x] = (q1 * sn[x] + q2 * cs[x]) * gi; }
    }
    u32x4 t;
    LAS unsigned char* kr = lds + L2_KS + i * ST64 + 16 * gq;
    t.x = pk2(ka[0], ka[1]); t.y = pk2(ka[2], ka[3]); t.z = pk2(ka[4], ka[5]); t.w = pk2(ka[6], ka[7]); *(LAS u32x4*)kr = t;
    t.x = pk2(kb[0], kb[1]); t.y = pk2(kb[2], kb[3]); t.z = pk2(kb[4], kb[5]); t.w = pk2(kb[6], kb[7]); *(LAS u32x4*)(kr + 64) = t;
    if (WITH_Q) { LAS unsigned char* qr = lds + L2_QS + i * ST64 + 16 * gq;
        t.x = pk2(qa[0], qa[1]); t.y = pk2(qa[2], qa[3]); t.z = pk2(qa[4], qa[5]); t.w = pk2(qa[6], qa[7]); *(LAS u32x4*)qr = t;
        t.x = pk2(qb[0], qb[1]); t.y = pk2(qb[2], qb[3]); t.z = pk2(qb[4], qb[5]); t.w = pk2(qb[6], qb[7]); *(LAS u32x4*)(qr + 64) = t; }
#pragma unroll
    for (int y = 0; y < 4; ++y) *(LAS u32x4*)(lds + L2_VS + i * ST128 + 64 * gq + 16 * y) = vv[y];
}

__device__ __forceinline__ void ret_kv_unit(LAS unsigned char* lds, const bf16* K, const bf16* V, const float* rope, float* KVout, int b, int h, int c, int tid) {
    const float lg = lgamma_h(h);
    ret_load_chunk<false>(lds, K, K, V, rope, b * 2048 + c * 128, c * 128, h, lg, tid);
    __syncthreads();
    const int w = __builtin_amdgcn_readfirstlane(tid >> 6), lane = tid & 63, l15 = lane & 15, q4 = lane >> 4, qq = (lane >> 2) & 3, p = lane & 3;
    const int dt = w & 3, et0 = (w >> 2) * 4, rloc = 4 * q4 + qq;
    const LAS unsigned char* kA = lds + L2_KS + rloc * ST64 + (16 * dt + 4 * p) * 2;
    const LAS unsigned char* vB = lds + L2_VS + rloc * ST128 + (4 * p) * 2;
    f32x4 kv[4];
#pragma unroll
    for (int x = 0; x < 4; ++x) kv[x] = (f32x4){0.f, 0.f, 0.f, 0.f};
#pragma unroll
    for (int ks = 0; ks < 4; ++ks) { const bf16x8 a = cat8(trread(kA + (32 * ks) * ST64), trread(kA + (32 * ks + 16) * ST64));
#pragma unroll
        for (int x = 0; x < 4; ++x) { const bf16x8 bb = cat8(trread(vB + (32 * ks) * ST128 + 32 * (et0 + x)), trread(vB + (32 * ks + 16) * ST128 + 32 * (et0 + x))); kv[x] = MFMA16(a, bb, kv[x]); } }
#pragma unroll
    for (int x = 0; x < 4; ++x)
#pragma unroll
        for (int r = 0; r < 4; ++r) KVout[(16 * dt + 4 * q4 + r) * 128 + 16 * (et0 + x) + l15] = kv[x][r];
    __syncthreads();
}

__device__ __forceinline__ void ret_scan(const float* KVB, bf16* SCB, float* Sfin  , int gtid, int gthreads) {
    for (int idx = gtid; idx < 64 * 2048; idx += gthreads) { const int bh = idx >> 11, e4 = (idx & 2047) * 4; const float lg = lgamma_h(bh & 7);
        const float gam = __expf(lg), cd = __expf(128.f * lg), g127 = __expf(127.f * lg);
        const float* kvp = KVB + (size_t)bh * 16 * 8192 + e4; bf16* scp = SCB + (size_t)bh * 16 * 8192 + e4;
        f32x4 kvv[16];
#pragma unroll
        for (int c = 0; c < 16; ++c) kvv[c] = *(const f32x4*)(kvp + c * 8192);
        f32x4 acc = (f32x4){0.f, 0.f, 0.f, 0.f};
#pragma unroll
        for (int c = 0; c < 16; ++c) { u32x2 t; t.x = pk2(gam * acc[0], gam * acc[1]); t.y = pk2(gam * acc[2], gam * acc[3]); *(u32x2*)(scp + c * 8192) = t; acc = acc * cd + kvv[c] * g127; }
        *(f32x4*)(Sfin + (size_t)bh * 8192 + e4) = acc; }
}

struct R2Regs { u32x4 klo, khi, qlo, qhi, vv[4], sc[2]; };
__device__ __forceinline__ void ret_out_fetch(R2Regs& R, const bf16* Q, const bf16* K, const bf16* V, const bf16* G, const float* rope, const bf16* SC, int b, int h, int c, int tid) {
    const int row0 = b * 2048 + c * 128, i = tid >> 2, gq = tid & 3; const size_t rb = (size_t)(row0 + i) * 512 + h * 64 + 8 * gq;
    R.klo = *(const u32x4*)(K + rb); R.khi = *(const u32x4*)(K + rb + 32); R.qlo = *(const u32x4*)(Q + rb); R.qhi = *(const u32x4*)(Q + rb + 32);
#pragma unroll
    for (int y = 0; y < 4; ++y) R.vv[y] = *(const u32x4*)(V + (size_t)(row0 + i) * 1024 + h * 128 + 32 * gq + 8 * y);
#pragma unroll
    for (int y = 0; y < 2; ++y) { const int idx = tid + 512 * y; R.sc[y] = *(const u32x4*)(SC + (idx >> 4) * 128 + (idx & 15) * 8); }
}
__device__ __forceinline__ void ret_out_stage(LAS unsigned char* lds, const R2Regs& R, const bf16* G, const float* rope, u32x4 (&gpre)[4], int b, int h, int c, int tid) {
    const float lg = lgamma_h(h); const int i = tid >> 2, gq = tid & 3;
    const f32x4* rp = (const f32x4*)(rope + ((size_t)(c * 128 + i) * 32 + 8 * gq) * 2);
    const f32x4 r0 = rp[0], r1 = rp[1], r2 = rp[2], r3 = rp[3];
    {   const int row0 = b * 2048 + c * 128, w_ = tid >> 6, lane_ = tid & 63;
#pragma unroll
        for (int y = 0; y < 4; ++y) { const int idx = lane_ + 64 * y; gpre[y] = *(const u32x4*)(G + (size_t)(row0 + 16 * w_ + (idx >> 4)) * 1024 + h * 128 + (idx & 15) * 8); } }
    const float cs[8] = {r0[0], r0[2], r1[0], r1[2], r2[0], r2[2], r3[0], r3[2]}, sn[8] = {r0[1], r0[3], r1[1], r1[3], r2[1], r2[3], r3[1], r3[3]};
    const unsigned ql[4] = {R.qlo.x, R.qlo.y, R.qlo.z, R.qlo.w}, qh[4] = {R.qhi.x, R.qhi.y, R.qhi.z, R.qhi.w}, kl[4] = {R.klo.x, R.klo.y, R.klo.z, R.klo.w}, kh[4] = {R.khi.x, R.khi.y, R.khi.z, R.khi.w};
    const float gi = __expf((float)i * lg) * 0.125f, gk = __expf(-(float)i * lg);
    float qa[8], qb[8], ka[8], kb[8];
#pragma unroll
    for (int x = 0; x < 8; ++x) {
        const float k1 = (x & 1) ? bfhi(kl[x >> 1]) : bflo(kl[x >> 1]), k2 = (x & 1) ? bfhi(kh[x >> 1]) : bflo(kh[x >> 1]);
        ka[x] = (k1 * cs[x] - k2 * sn[x]) * gk; kb[x] = (k1 * sn[x] + k2 * cs[x]) * gk;
        const float q1 = (x & 1) ? bfhi(ql[x >> 1]) : bflo(ql[x >> 1]), q2 = (x & 1) ? bfhi(qh[x >> 1]) : bflo(qh[x >> 1]);
        qa[x] = (q1 * cs[x] - q2 * sn[x]) * gi; qb[x] = (q1 * sn[x] + q2 * cs[x]) * gi;
    }
    u32x4 t;
    LAS unsigned char* kr = lds + L2_KS + i * ST64 + 16 * gq;
    t.x = pk2(ka[0], ka[1]); t.y = pk2(ka[2], ka[3]); t.z = pk2(ka[4], ka[5]); t.w = pk2(ka[6], ka[7]); *(LAS u32x4*)kr = t;
    t.x = pk2(kb[0], kb[1]); t.y = pk2(kb[2], kb[3]); t.z = pk2(kb[4], kb[5]); t.w = pk2(kb[6], kb[7]); *(LAS u32x4*)(kr + 64) = t;
    LAS unsigned char* qr = lds + L2_QS + i * ST64 + 16 * gq;
    t.x = pk2(qa[0], qa[1]); t.y = pk2(qa[2], qa[3]); t.z = pk2(qa[4], qa[5]); t.w = pk2(qa[6], qa[7]); *(LAS u32x4*)qr = t;
    t.x = pk2(qb[0], qb[1]); t.y = pk2(qb[2], qb[3]); t.z = pk2(qb[4], qb[5]); t.w = pk2(qb[6], qb[7]); *(LAS u32x4*)(qr + 64) = t;
#pragma unroll
    for (int y = 0; y < 4; ++y) *(LAS u32x4*)(lds + L2_VS + i * ST128 + 64 * gq + 16 * y) = R.vv[y];
#pragma unroll
    for (int y = 0; y < 2; ++y) { const int idx = tid + 512 * y, d = idx >> 4, ch = idx & 15; *(LAS u32x4*)(lds + L2_SS + d * ST128 + ch * 16) = R.sc[y]; }
}
__device__ __forceinline__ void ret_out_compute(LAS unsigned char* lds, bf16* G, const float* gn_g, const u32x4 (&gpre)[4], int b, int h, int c, int tid) {
    const int row0 = b * 2048 + c * 128;
    const int w = __builtin_amdgcn_readfirstlane(tid >> 6), lane = tid & 63, l15 = lane & 15, q4 = lane >> 4, qq = (lane >> 2) & 3, p = lane & 3;
    const int rloc = 4 * q4 + qq;
    const LAS unsigned char* qrow = lds + L2_QS + (16 * w + l15) * ST64 + 8 * q4;
    const bf16x8 Qf0 = cat8(ld8(qrow), ld8(qrow + 32)), Qf1 = cat8(ld8(qrow + 64), ld8(qrow + 96));
    const LAS unsigned char* vB = lds + L2_VS + rloc * ST128 + 8 * p;
    const LAS unsigned char* sB = lds + L2_SS + rloc * ST128 + 8 * p;
    f32x4 o[8];
#pragma unroll
    for (int et = 0; et < 8; ++et) o[et] = (f32x4){0.f, 0.f, 0.f, 0.f};
    const int irow = 16 * w + l15;
    for (int ks = 0; ks <= (w >> 1); ++ks) {
        const LAS unsigned char* k0 = lds + L2_KS + (32 * ks + l15) * ST64 + 8 * q4; const LAS unsigned char* k1 = k0 + 16 * ST64;
        f32x4 s0 = (f32x4){0.f, 0.f, 0.f, 0.f}, s1 = s0;
        s0 = MFMA16(cat8(ld8(k0), ld8(k0 + 32)), Qf0, s0); s0 = MFMA16(cat8(ld8(k0 + 64), ld8(k0 + 96)), Qf1, s0);
        s1 = MFMA16(cat8(ld8(k1), ld8(k1 + 32)), Qf0, s1); s1 = MFMA16(cat8(ld8(k1 + 64), ld8(k1 + 96)), Qf1, s1);
        const int j0 = 32 * ks + 4 * q4;
#pragma unroll
        for (int r = 0; r < 4; ++r) { s0[r] = (j0 + r <= irow) ? s0[r] : 0.f; s1[r] = (j0 + 16 + r <= irow) ? s1[r] : 0.f; }
        u32x4 pw; pw.x = pk2(s0[0], s0[1]); pw.y = pk2(s0[2], s0[3]); pw.z = pk2(s1[0], s1[1]); pw.w = pk2(s1[2], s1[3]);
        const bf16x8 pa = __builtin_bit_cast(bf16x8, pw);
#pragma unroll
        for (int et = 0; et < 8; ++et) { const bf16x8 bb = cat8(trread(vB + (32 * ks) * ST128 + 32 * et), trread(vB + (32 * ks + 16) * ST128 + 32 * et)); o[et] = MFMA16(pa, bb, o[et]); }
    }
#pragma unroll
    for (int ks = 0; ks < 2; ++ks) { const bf16x8 a = ks ? Qf1 : Qf0;
#pragma unroll
        for (int et = 0; et < 8; ++et) { const bf16x8 bb = cat8(trread(sB + (32 * ks) * ST128 + 32 * et), trread(sB + (32 * ks + 16) * ST128 + 32 * et)); o[et] = MFMA16(a, bb, o[et]); } }
    float gg[8];
#pragma unroll
    for (int et = 0; et < 8; ++et) gg[et] = gn_g[h * 128 + 16 * et + l15];
#pragma unroll
    for (int r = 0; r < 4; ++r) {
        float s = 0.f;
#pragma unroll
        for (int et = 0; et < 8; ++et) s += o[et][r];
        s += __shfl_xor(s, 1); s += __shfl_xor(s, 2); s += __shfl_xor(s, 4); s += __shfl_xor(s, 8);
        const float mean = s * (1.f / 128.f); float vs = 0.f;
#pragma unroll
        for (int et = 0; et < 8; ++et) { const float d = o[et][r] - mean; vs += d * d; }
        vs += __shfl_xor(vs, 1); vs += __shfl_xor(vs, 2); vs += __shfl_xor(vs, 4); vs += __shfl_xor(vs, 8);
        const float rstd = 1.0f / sqrtf(vs * (1.f / 128.f) + 1e-5f);
        LAS bf16* yr = (LAS bf16*)(lds + L2_YS + (16 * w + 4 * q4 + r) * STY) + l15;
#pragma unroll
        for (int et = 0; et < 8; ++et) yr[16 * et] = (bf16)f2bf((o[et][r] - mean) * rstd * gg[et]);
    }
#pragma unroll
    for (int y = 0; y < 4; ++y) { const int idx = lane + 64 * y, rr = 16 * w + (idx >> 4), ch = idx & 15;
        const u32x4 yv = *(const LAS u32x4*)(lds + L2_YS + rr * STY + ch * 16);
        bf16* gp = G + (size_t)(row0 + rr) * 1024 + h * 128 + ch * 8; const u32x4 gv = gpre[y];
        u32x4 ov;
        ov.x = pk2(siluf_(bflo(gv.x)) * bflo(yv.x), siluf_(bfhi(gv.x)) * bfhi(yv.x)); ov.y = pk2(siluf_(bflo(gv.y)) * bflo(yv.y), siluf_(bfhi(gv.y)) * bfhi(yv.y));
        ov.z = pk2(siluf_(bflo(gv.z)) * bflo(yv.z), siluf_(bfhi(gv.z)) * bfhi(yv.z)); ov.w = pk2(siluf_(bflo(gv.w)) * bflo(yv.w), siluf_(bfhi(gv.w)) * bfhi(yv.w));
        *(u32x4*)gp = ov; }
    __syncthreads();
}


__device__ __forceinline__ void ret_sample_unit(LAS unsigned char* lds, const bf16* Q, const bf16* K, const bf16* V, bf16* G, const float* rope, const float* gn_g, const float* S0, float* Sout, int bs, int h, int tid) {
    LAS float* qf = (LAS float*)lds; LAS float* kf = qf + 512; LAS float* vf = kf + 512; LAS float* sc = vf + 1024; LAS float* oc = sc + 64; LAS float* ob = oc + 4096;
    const int w = tid >> 6, lane = tid & 63; const float lg = lgamma_h(h); const int row0 = NPROMPT + bs * 8;
    {   const int which = tid >> 8, t2 = tid & 255, i = t2 >> 5, d = t2 & 31; const bf16* src = which ? K : Q; const size_t rb = (size_t)(row0 + i) * 512 + h * 64 + d;
        const float x1 = bf2f(src[rb]), x2 = bf2f(src[rb + 32]); const float cs = rope[((size_t)(2048 + i) * 32 + d) * 2], sn = rope[((size_t)(2048 + i) * 32 + d) * 2 + 1];
        const float scale = which ? 1.0f : 0.125f; LAS float* dst = which ? kf : qf;
        dst[i * 64 + d] = (x1 * cs - x2 * sn) * scale; dst[i * 64 + 32 + d] = (x1 * sn + x2 * cs) * scale; }
#pragma unroll
    for (int y = 0; y < 2; ++y) { const int idx = tid + 512 * y, j = idx >> 7, e = idx & 127; vf[idx] = bf2f(V[(size_t)(row0 + j) * 1024 + h * 128 + e]); }
    __syncthreads();
    if (tid < 64) { const int i = tid >> 3, j = tid & 7; float s = 0.f;
        if (j <= i) { for (int d = 0; d < 64; ++d) s += qf[i * 64 + d] * kf[j * 64 + d]; s *= __expf((float)(i - j) * lg); }
        sc[tid] = s; }
    const int e = tid & 127, dg = tid >> 7;
    float Sreg[16];
#pragma unroll
    for (int dd = 0; dd < 16; ++dd) Sreg[dd] = S0[(dg * 16 + dd) * 128 + e];
#pragma unroll
    for (int i = 0; i < 8; ++i) { float p = 0.f;
#pragma unroll
        for (int dd = 0; dd < 16; ++dd) p += qf[i * 64 + dg * 16 + dd] * Sreg[dd];
        oc[(dg * 8 + i) * 128 + e] = p; }
    const float g8 = __expf(8.f * lg);
    float vdec[8];
#pragma unroll
    for (int j = 0; j < 8; ++j) vdec[j] = __expf((float)(7 - j) * lg) * vf[j * 128 + e];
#pragma unroll
    for (int dd = 0; dd < 16; ++dd) { float acc = Sreg[dd] * g8;
#pragma unroll
        for (int j = 0; j < 8; ++j) acc += kf[j * 64 + dg * 16 + dd] * vdec[j];
        Sout[(dg * 16 + dd) * 128 + e] = acc; }
    __syncthreads();
#pragma unroll
    for (int y = 0; y < 2; ++y) { const int idx = tid + 512 * y, i = idx >> 7, ee = idx & 127;
        float o = (oc[(0 + i) * 128 + ee] + oc[(8 + i) * 128 + ee] + oc[(16 + i) * 128 + ee] + oc[(24 + i) * 128 + ee]) * __expf((float)(i + 1) * lg);
        for (int j = 0; j <= i; ++j) o += sc[i * 8 + j] * vf[j * 128 + ee];
        ob[idx] = o; }
    __syncthreads();
    {   const int i = w; const float v0 = ob[i * 128 + lane], v1 = ob[i * 128 + 64 + lane];
        const float mean = wave_sum(v0 + v1) * (1.f / 128.f); const float d0 = v0 - mean, d1 = v1 - mean;
        const float rstd = 1.0f / sqrtf(wave_sum(d0 * d0 + d1 * d1) * (1.f / 128.f) + 1e-5f);
        bf16* gp = G + (size_t)(row0 + i) * 1024 + h * 128 + lane;
        const float g0 = bf2f(gp[0]), g1 = bf2f(gp[64]);
        gp[0] = (bf16)f2bf(siluf_(g0) * d0 * rstd * gn_g[h * 128 + lane]); gp[64] = (bf16)f2bf(siluf_(g1) * d1 * rstd * gn_g[h * 128 + 64 + lane]); }
    __syncthreads();
}

template <int NT> __device__ __forceinline__ void conf_unit(LAS unsigned char* lds, const bf16* CA, const bf16* CB, bf16* XCS, const float* cw, const float* cbias, const float* lng, const float* lnb,
                                                             const float* state, float* state_out, int seqrow0, int t0, int T, int tid) {
    LAS float* U = (LAS float*)lds; LAS float* CV = U + 46 * 512;
    const int c = tid, w = tid >> 6, lane = tid & 63;
    float wreg[31];
#pragma unroll
    for (int k = 0; k < 31; ++k) wreg[k] = cw[k * 512 + c];
    const float bias = cbias[c];
#pragma unroll
    for (int itn = 0; itn < ((30 + NT) * 64 + NTHREADS - 1) / NTHREADS; ++itn) { const int it = tid + itn * NTHREADS; if (it < (30 + NT) * 64) {
        const int r = it >> 6, c0 = (it & 63) * 8; f32x4 u0 = (f32x4){0.f, 0.f, 0.f, 0.f}, u1 = u0;
        if (state && r < 30) { u0 = *(const f32x4*)(state + r * 512 + c0); u1 = *(const f32x4*)(state + r * 512 + c0 + 4); }
        else { const int t = t0 - 30 + r;
            if (t >= 0) { const size_t gi = (size_t)(seqrow0 + t) * 512 + c0; const u32x4 av = *(const u32x4*)(CA + gi);
                u0[0] = bflo(av.x); u0[1] = bfhi(av.x); u0[2] = bflo(av.y); u0[3] = bfhi(av.y); u1[0] = bflo(av.z); u1[1] = bfhi(av.z); u1[2] = bflo(av.w); u1[3] = bfhi(av.w);
                if (!state && r >= 30 && t >= T - 30) { float* so = state_out + (size_t)(t - (T - 30)) * 512 + c0; *(f32x4*)so = u0; *(f32x4*)(so + 4) = u1; } } }
        *(LAS f32x4*)(U + r * 512 + c0) = u0; *(LAS f32x4*)(U + r * 512 + c0 + 4) = u1;
    } }
    __syncthreads();
    if (state) { for (int it = tid; it < 30 * 128; it += NTHREADS) { const int rr = it >> 7, c4 = (it & 127) * 4; *(f32x4*)(state_out + rr * 512 + c4) = *(const LAS f32x4*)(U + (rr + NT) * 512 + c4); } }
    float cv[NT];
#pragma unroll
    for (int tt = 0; tt < NT; ++tt) cv[tt] = bias;
#pragma unroll
    for (int r = 0; r < 30 + NT; ++r) { const float u = U[r * 512 + c];
#pragma unroll
        for (int tt = 0; tt < NT; ++tt) { if (r - tt >= 0 && r - tt <= 30) cv[tt] += wreg[r - tt] * u; } }
#pragma unroll
    for (int tt = 0; tt < NT; ++tt) CV[tt * 512 + c] = cv[tt];
    __syncthreads();
    for (int tt = w; tt < NT; tt += 8) {
        const f32x4 x0 = *(const LAS f32x4*)(CV + tt * 512 + lane * 8), x1 = *(const LAS f32x4*)(CV + tt * 512 + lane * 8 + 4);
        const float mean = wave_sum((x0[0] + x0[1]) + (x0[2] + x0[3]) + (x1[0] + x1[1]) + (x1[2] + x1[3])) * (1.f / 512.f);
        const f32x4 d0 = x0 - mean, d1 = x1 - mean;
        const float var = wave_sum((d0[0] * d0[0] + d0[1] * d0[1]) + (d0[2] * d0[2] + d0[3] * d0[3]) + (d1[0] * d1[0] + d1[1] * d1[1]) + (d1[2] * d1[2] + d1[3] * d1[3])) * (1.f / 512.f);
        const float rstd = 1.0f / sqrtf(var + 1e-5f);
        const f32x4 g0 = *(const f32x4*)(lng + lane * 8), g1 = *(const f32x4*)(lng + lane * 8 + 4), b0 = *(const f32x4*)(lnb + lane * 8), b1 = *(const f32x4*)(lnb + lane * 8 + 4);
        const f32x4 y0 = d0 * rstd * g0 + b0, y1 = d1 * rstd * g1 + b1;
        u32x4 o; o.x = pk2(siluf_(y0[0]), siluf_(y0[1])); o.y = pk2(siluf_(y0[2]), siluf_(y0[3])); o.z = pk2(siluf_(y1[0]), siluf_(y1[1])); o.w = pk2(siluf_(y1[2]), siluf_(y1[3]));
        *(u32x4*)(XCS + (size_t)(seqrow0 + t0 + tt) * 1024 + lane * 8) = o;
    }
    __syncthreads();
}

__device__ __forceinline__ void sconv_unit(const bf16* SB, const bf16* SCC, const bf16* SX, bf16* XCS, const float* scw, const float* state_l  , float* outp_l  , float* outs_l  , int tile, int tid) {
#pragma unroll
    for (int y = 0; y < 2; ++y) {
        const int item = tid + 512 * y, R = tile * 16 + (item >> 6), c0 = (item & 63) * 8;
        const bool prompt = R < NPROMPT; const int t = prompt ? (R & 2047) : ((R - NPROMPT) & 7); const int sq = prompt ? (R >> 11) : ((R - NPROMPT) >> 3);
        float us[3][8];
#pragma unroll
        for (int k = 0; k < 3; ++k) { const int tp = t - 2 + k;
            if (tp >= 0) { const size_t gi = (size_t)(R - 2 + k) * 512 + c0; const u32x4 a = *(const u32x4*)(SCC + gi);
                const unsigned aw[4] = {a.x, a.y, a.z, a.w};
#pragma unroll
                for (int x = 0; x < 4; ++x) { us[k][2 * x] = bflo(aw[x]); us[k][2 * x + 1] = bfhi(aw[x]); } }
            else if (prompt) {
#pragma unroll
                for (int x = 0; x < 8; ++x) us[k][x] = 0.f; }
            else { const float* sp = state_l + ((size_t)sq * 2 + (2 + tp)) * 512 + c0; const f32x4 s0 = *(const f32x4*)sp, s1 = *(const f32x4*)(sp + 4);
#pragma unroll
                for (int x = 0; x < 4; ++x) { us[k][x] = s0[x]; us[k][4 + x] = s1[x]; } } }
        const u32x4 sbv = *(const u32x4*)(SB + (size_t)R * 512 + c0); const unsigned sw[4] = {sbv.x, sbv.y, sbv.z, sbv.w};
        float o[8];
#pragma unroll
        for (int x = 0; x < 8; ++x) { const float sv = scw[c0 + x] * us[0][x] + scw[512 + c0 + x] * us[1][x] + scw[1024 + c0 + x] * us[2][x];
            o[x] = ((x & 1) ? bfhi(sw[x >> 1]) : bflo(sw[x >> 1])) * sv; }
        u32x4 ow; ow.x = pk2(o[0], o[1]); ow.y = pk2(o[2], o[3]); ow.z = pk2(o[4], o[5]); ow.w = pk2(o[6], o[7]);
        *(u32x4*)(XCS + (size_t)R * 1024 + 512 + c0) = ow;
        const int tl = prompt ? 2046 : 6;
        if (t >= tl) { float* op = (prompt ? outp_l : outs_l) + ((size_t)sq * 2 + (t - tl)) * 512 + c0;
            *(f32x4*)op = (f32x4){us[2][0], us[2][1], us[2][2], us[2][3]}; *(f32x4*)(op + 4) = (f32x4){us[2][4], us[2][5], us[2][6], us[2][7]}; }
    }
}


#define XB_TMO      128
#define XB_XCNT(j)  (256  + 64 * (j))
#define XB_XSUB(j)  (1280 + 64 * (j))
#define XB_XGEN(j)  (2304 + 64 * (j))
#define XB_TOP      3328
#define XB_TOPGEN   3392
#define XCD_BAR_WORDS 3456
#define XB_SPIN_CAP (1u << 18)

__device__ __forceinline__ unsigned xb_ld(unsigned* p)              { return __hip_atomic_load(p, __ATOMIC_RELAXED, __HIP_MEMORY_SCOPE_AGENT); }
__device__ __forceinline__ unsigned xb_add(unsigned* p, unsigned v) { return __hip_atomic_fetch_add(p, v, __ATOMIC_RELAXED, __HIP_MEMORY_SCOPE_AGENT); }
__device__ __forceinline__ unsigned xb_xcc_id() { return (unsigned)__builtin_amdgcn_s_getreg((3 << 11) | 20) & 0xFu; }
#define XB_SPIN(cond, bar) do { unsigned _sp = 0; while (cond) { __builtin_amdgcn_s_sleep(1); \
    if ((++_sp & 255u) == 0u) { if (xb_ld(&(bar)[XB_TMO])) break; if (_sp > XB_SPIN_CAP) { atomicAdd(&(bar)[XB_TMO], 1u); break; } } } } while (0)

struct XcdBarrier {
    unsigned* bar; unsigned x;
    volatile LAS unsigned* st;
};

__device__ __forceinline__ XcdBarrier xcd_barrier_post(unsigned* bar, volatile LAS unsigned* st) {
    XcdBarrier b; b.bar = bar; b.x = xb_xcc_id(); b.st = st;
    if (threadIdx.x == 0) (void)xb_add(&bar[XB_XCNT(b.x)], 1u);
    return b;
}
__device__ __forceinline__ void xcd_barrier_complete(unsigned* bar, unsigned x, unsigned& nloc, unsigned& nx) {
    const unsigned G = gridDim.x * gridDim.y * gridDim.z;
    unsigned sum, cnt, mine, sp = 0u;
    for (;;) {
        sum = 0u; cnt = 0u; mine = 0u;
#pragma unroll
        for (unsigned j = 0; j < 16; ++j) { const unsigned c = xb_ld(&bar[XB_XCNT(j)]); sum += c; cnt += (c > 0u) ? 1u : 0u; mine = (j == x) ? c : mine; }
        if (sum == G) break;
        __builtin_amdgcn_s_sleep(1);
        if ((++sp & 255u) == 0u) { if (xb_ld(&bar[XB_TMO])) break; if (sp > XB_SPIN_CAP) { atomicAdd(&bar[XB_TMO], 1u); break; } }
    }
    nloc = mine > 0u ? mine : 1u; nx = cnt > 0u ? cnt : 1u;
}

__device__ __forceinline__ void xcd_barrier(const XcdBarrier& b) {
    asm volatile("s_waitcnt vmcnt(0)" ::: "memory");
    __syncthreads();
    if (threadIdx.x == 0) {
        unsigned* bar = b.bar;
        __builtin_amdgcn_s_waitcnt(0);
        unsigned nloc = b.st[0], nx = b.st[1];
        if (nloc == 0u) { xcd_barrier_complete(bar, b.x, nloc, nx); b.st[0] = nloc; b.st[1] = nx; }
        const unsigned old = xb_add(&bar[XB_XSUB(b.x)], 1u);
        const unsigned gen = old / nloc;
        if (old + 1u == (gen + 1u) * nloc) {
            __builtin_amdgcn_fence(__ATOMIC_RELEASE, "agent");
            asm volatile("s_waitcnt vmcnt(0)" ::: "memory");
            const unsigned og = xb_add(&bar[XB_TOP], 1u);
            const unsigned tg = og / nx;
            if (og + 1u == (tg + 1u) * nx) xb_add(&bar[XB_TOPGEN], 1u);
            else XB_SPIN(xb_ld(&bar[XB_TOPGEN]) == tg, bar);
            __builtin_amdgcn_fence(__ATOMIC_ACQUIRE, "agent");
            xb_add(&bar[XB_XGEN(b.x)], 1u);
            asm volatile("s_waitcnt vmcnt(0)" ::: "memory");
        } else {
            XB_SPIN(xb_ld(&bar[XB_XGEN(b.x)]) == gen, bar);
            __builtin_amdgcn_fence(__ATOMIC_ACQUIRE, "agent");
            asm volatile("s_waitcnt vmcnt(0)" ::: "memory");
        }
    }
    __syncthreads();
}


__global__ void __launch_bounds__(NTHREADS, 2) mega_fwd(Args a) {
    extern __shared__ __attribute__((aligned(16))) unsigned char lds_raw[];
    cg::grid_group grid = cg::this_grid();
    LAS unsigned char* lds = (LAS unsigned char*)lds_raw;
    const int G = gridDim.x, bid0 = blockIdx.x, NGW = G * NWAVES;
    volatile LAS unsigned* bst = (volatile LAS unsigned*)(lds + 131072 + 64);
    if (threadIdx.x < 2) bst[threadIdx.x] = 0u;
    __syncthreads();
    const unsigned xcc_x = (unsigned)__builtin_amdgcn_readfirstlane((int)xcd_barrier_post((unsigned*)(a.ws + WS_BAR), bst).x);
#define GRID_BAR() do { ArgsP apb_ = (ArgsP)__builtin_amdgcn_kernarg_segment_ptr(); asm volatile("" : "+s"(apb_)); unsigned x_ = xcc_x; asm volatile("" : "+s"(x_)); XcdBarrier b_; b_.bar = (unsigned*)(apb_->ws + WS_BAR); b_.x = x_; b_.st = bst; PR_T0(10); xcd_barrier(b_); PR_T1(10); } while (0)
#ifdef PROBE_CAT
    unsigned long long pr_acc = 0ull, pr_t0 = 0ull;
#define PR_T0(cat) do { if ((cat) == PROBE_CAT) pr_t0 = __builtin_amdgcn_s_memrealtime(); } while (0)
#define PR_T1(cat) do { if ((cat) == PROBE_CAT) pr_acc += __builtin_amdgcn_s_memrealtime() - pr_t0; } while (0)
#else
#define PR_T0(cat) do {} while (0)
#define PR_T1(cat) do {} while (0)
#endif
#define PHASE_BEGIN ArgsP ap = (ArgsP)__builtin_amdgcn_kernarg_segment_ptr(); asm volatile("" : "+s"(ap)); unsigned char* ws = ap->ws; float* XW = ap->out; int tid = threadIdx.x; asm volatile("" : "+v"(tid)); int bid = bid0; asm volatile("" : "+s"(bid)); \
    const int lane = tid & 63, wave = __builtin_amdgcn_readfirstlane(tid >> 6), gw = bid * NWAVES + wave; \
    float* ADA = (float*)(ws + WS_ADA); float* ROPE = (float*)(ws + WS_ROPE); bf16* H = (bf16*)(ws + WS_H); bf16* U = (bf16*)(ws + WS_U); \
    (void)lane; (void)wave; (void)gw; (void)ADA; (void)ROPE; (void)H; (void)U; (void)XW;
#define GEMM_PHASE(EPI, Aptr, Bptr, Mm, Nn, Kk, lda_, ldb_, ...) { pg8::Gemm g{(const bf16*)(Aptr), (const bf16*)(Bptr), (Mm), (Nn), (Kk), (lda_), (ldb_), 1 << 30, 0l}; pg8::StaticOrder S; S.init((Mm), (Nn), G, bid, (Kk)); \
        EPI E{__VA_ARGS__}; pg8::gemm_phase<EPI, pg8::StaticOrder, true, true>(lds, g, S, E); }
#define GEMM_PHASE_SPLIT(EPI, Aptr, Bptr, Nn, Kk, lda_, ldb_, SPL, ...) { pg8::Gemm g{(const bf16*)(Aptr), (const bf16*)(Bptr), MTOK, (Nn), (Kk), (lda_), (ldb_), 1 << 30, 0l}; pg8::SplitOrder S; S.init(MTOK, (Nn), G, bid, (Kk), (SPL)); \
        EPI E{__VA_ARGS__}; pg8::gemm_phase<EPI, pg8::SplitOrder, true, true>(lds, g, S, E); }

    {   PHASE_BEGIN
        PR_T0(1);
#if PHASES & 1
        convert_ada_weights(ap, ws, lds, gw, NGW, wave, lane);
#endif
        bf16* CS = (bf16*)(ws + WS_CSIL);
        for (int i = bid * NTHREADS + tid; i < 256 * 1024; i += G * NTHREADS) { const int r = i >> 10, c = i & 1023; float v = 0.f;
            if (r < 8) v = siluf_(ap->in[2][r * 1024 + c]); else if (r < NSEQ) v = siluf_(ap->in[3][(r - 8) * 1024 + c]);
            CS[i] = (bf16)f2bf(v); }
        for (int i = bid * NTHREADS + tid; i < 2056 * 32; i += G * NTHREADS) { const int p = i >> 5, k = i & 31; const int pos = p < 2048 ? p : 16384 + (p - 2048);
            double f = 0.15915494309189535; for (int q = 0; q < k; ++q) f *= 0.7498942093324559;
            double rv = (double)pos * f; rv -= __builtin_floor(rv); const float fr = (float)rv;
            ROPE[2 * i] = __builtin_amdgcn_cosf(fr); ROPE[2 * i + 1] = __builtin_amdgcn_sinf(fr); }
        PR_T1(1);
    }
    grid.sync();
    {   PHASE_BEGIN
        GEMM_PHASE(EpiAda, ws + WS_CSIL, ws + WS_WADA, 256, 2 * NADA, 1024, 1024, 1024, ADA, ap->in[8])
        __syncthreads();
        if (G >= 136) { if (bid >= 72) { convert_layer_main(ap, ws, 0, lds, (bid - 72) * NWAVES + wave, (G - 72) * NWAVES, wave, lane); convert_layer_w2b(ap, ws, 0, lds, (bid - 72) * NWAVES + wave, (G - 72) * NWAVES, wave, lane); } }
        else { convert_layer_main(ap, ws, 0, lds, gw, NGW, wave, lane); convert_layer_w2b(ap, ws, 0, lds, gw, NGW, wave, lane); }
    }
    GRID_BAR();

#pragma unroll 1
    for (int l = 0; l < 2; ++l) {
        {   PHASE_BEGIN
            const float* ada_l = ADA + (size_t)l * NSEQ * NADA;
            PR_T0(2);
            if (l == 0) rmsmod_phase(ap->in[0], ap->in[1], XW, ap->in[9], ada_l, 0, H, nullptr, 0, gw, NGW, lane);
            else { rmsmod_phase(XW, XW + (size_t)NPROMPT * DM, nullptr, ap->in[9] + l * DM, ada_l, 0, H, (const float*)(ws + WS_KVB), 4, gw, NGW, lane);
                convert_layer_w2b(ap, ws, l, lds, gw, NGW, wave, lane);
            } PR_T1(2); }
        GRID_BAR();
        {   PHASE_BEGIN
#if PHASES & 2
            GEMM_PHASE(EpiSwiglu, H, ws + WS_W13A, MTOK, 2 * DFF, 1024, 1024, 1024, U)
#ifdef PROBE_UP
            GEMM_PHASE(EpiSwiglu, H, ws + WS_W13A, MTOK, 2 * DFF, 1024, 1024, 1024, U)
#endif
#endif
        }
        GRID_BAR();
        {   PHASE_BEGIN
            const float* ada_l = ADA + (size_t)l * NSEQ * NADA;
#if PHASES & 4
            GEMM_PHASE_SPLIT(EpiResid, U, ws + WS_W2A, DM, DFF, DFF, DFF, 4, XW, (float*)ws, l * NSEQ * NADA + 2 * 1024, 0.5f, DFF / 64)
#endif
        }
        GRID_BAR();
        {   PHASE_BEGIN
            const float* ada_l = ADA + (size_t)l * NSEQ * NADA;
            PR_T0(2); rmsmod_phase(XW, XW + (size_t)NPROMPT * DM, nullptr, ap->in[13] + l * DM, ada_l, 3, H, (const float*)(ws + WS_KVB), 4, gw, NGW, lane); PR_T1(2); }
        GRID_BAR();
        {   PHASE_BEGIN
#if PHASES & 16
            if (G >= 64) { pg8::Gemm g{(const bf16*)H, (const bf16*)(ws + WS_WIN), MTOK, INCOLS, 1024, 1024, 1024, 1 << 30, 0l}; pg8::WinOrder S; S.init(MTOK, G, bid, 1024);
                EpiWin E{ws}; pg8::gemm_phase<EpiWin, pg8::WinOrder, true, true>(lds, g, S, E); }
            else { GEMM_PHASE(EpiWin, H, ws + WS_WIN, MTOK, INCOLS, 1024, 1024, 1024, ws) }
#endif
        }
        GRID_BAR();
        {
            PHASE_BEGIN
            const bf16* Qb = (const bf16*)(ws + WS_Q); const bf16* Kb = (const bf16*)(ws + WS_K); const bf16* Vb = (const bf16*)(ws + WS_V); bf16* Gb = (bf16*)(ws + WS_G);
            bf16* XCS = H; float* out = XW;
            const float* gn_g = ap->in[16] + l * 1024;
            PR_T0(3);
            const bool defer = G >= 64; const int mb = defer ? bid - 8 : bid, mG = defer ? G - 8 : G;
            if (defer && bid < 8) { pg8::Gemm g{(const bf16*)H, (const bf16*)(ws + WS_WIN), MTOK, INCOLS, 1024, 1024, 1024, 1 << 30, 0l}; pg8::OneOrder S{32 + bid, 33, 16};
                EpiWin E{ws}; pg8::gemm_phase<EpiWin, pg8::OneOrder, true, true>(lds, g, S, E); }
#pragma unroll 1
            for (int u = mb; u >= 0 && u < 1024 + 1024 + 512 + 128 + 64; u += mG) {
                if (u < 1024) { const int bh = u >> 4, c = u & 15;
                    PR_T0(6); ret_kv_unit(lds, Kb, Vb, ROPE, (float*)(ws + WS_KVB) + (size_t)u * 8192, bh >> 3, bh & 7, c, tid); PR_T1(6);
                } else if (u < 2048) { const int v = u - 1024, bs = v >> 3, h = v & 7;
                    PR_T0(4); ret_sample_unit(lds, Qb, Kb, Vb, Gb, ROPE, gn_g, ap->in[4] + (((size_t)l * 128 + bs) * 8 + h) * 8192, out + O_RETS + (((size_t)l * 128 + bs) * 8 + h) * 8192, bs, h, tid); PR_T1(4);
                } else if (u < 2560) { const int v = u - 2048, b = v >> 7, ti = v & 127;
                    PR_T0(5); conf_unit<16>(lds, (const bf16*)(ws + WS_CA), (const bf16*)(ws + WS_CB), XCS, ap->in[18] + l * 31 * 512, ap->in[19] + l * 512, ap->in[20] + l * 512, ap->in[21] + l * 512,
                                  nullptr, out + O_CONFP + ((size_t)l * 8 + b) * 30 * 512, b * 2048, ti * 16, 2048, tid); PR_T1(5);
                } else if (u < 2688) { const int bs = u - 2560;
                    PR_T0(5); conf_unit<8>(lds, (const bf16*)(ws + WS_CA), (const bf16*)(ws + WS_CB), XCS, ap->in[18] + l * 31 * 512, ap->in[19] + l * 512, ap->in[20] + l * 512, ap->in[21] + l * 512,
                                 ap->in[5] + ((size_t)l * 128 + bs) * 30 * 512, out + O_CONFS + ((size_t)l * 128 + bs) * 30 * 512, NPROMPT + bs * 8, 0, 8, tid); PR_T1(5);
                } else {
                    PR_T0(7); sconv_unit((const bf16*)(ws + WS_SB), (const bf16*)(ws + WS_SCC), (const bf16*)(ws + WS_SX), XCS, ap->in[23] + l * 3 * 512, ap->in[6] + (size_t)l * 128 * 2 * 512,
                               out + O_SCP + (size_t)l * 8 * 2 * 512, out + O_SCS + (size_t)l * 128 * 2 * 512, 1024 + (u - 2688), tid); PR_T1(7);
                }
            }
            PR_T1(3);
        }
        GRID_BAR();
        {
            PHASE_BEGIN
            PR_T0(3); ret_scan((const float*)(ws + WS_KVB), (bf16*)(ws + WS_SCB), XW + O_RETP + (size_t)l * 64 * 8192, bid * NTHREADS + tid, G * NTHREADS); PR_T1(3); }
        GRID_BAR();
        {
            PHASE_BEGIN
            const bf16* Qb = (const bf16*)(ws + WS_Q); const bf16* Kb = (const bf16*)(ws + WS_K); const bf16* Vb = (const bf16*)(ws + WS_V); bf16* Gb = (bf16*)(ws + WS_G);
            const float* gn_g = ap->in[16] + l * 1024;
            PR_T0(3);
            const bool dedic = G >= 64;
            const int rb = dedic ? bid - 16 : bid, rG = dedic ? G - 16 : G;
            if (rb >= 0) {
                { int u = rb; if (u < 1024) { R2Regs R; u32x4 gpre[4]; const bf16* SCB_ = (const bf16*)(ws + WS_SCB);
                    ret_out_fetch(R, Qb, Kb, Vb, Gb, ROPE, SCB_ + (size_t)u * 8192, u >> 7, (u >> 4) & 7, u & 15, tid);
#pragma unroll 1
                    for (;;) {
                        ret_out_stage(lds, R, Gb, ROPE, gpre, u >> 7, (u >> 4) & 7, u & 15, tid); __syncthreads();
                        const int u1 = u + rG; const bool h1 = u1 < 1024;
                        if (h1) ret_out_fetch(R, Qb, Kb, Vb, Gb, ROPE, SCB_ + (size_t)u1 * 8192, u1 >> 7, (u1 >> 4) & 7, u1 & 15, tid);
                        ret_out_compute(lds, Gb, gn_g, gpre, u >> 7, (u >> 4) & 7, u & 15, tid);
                        if (!h1) break; u = u1; } } }
#pragma unroll 1
                for (int v = 512 + rb; v < 1024; v += rG) { const int b = v >> 7, ti = v & 127;
                    conf_unit<16>(lds, (const bf16*)(ws + WS_CA), (const bf16*)(ws + WS_CB), H, ap->in[18] + l * 31 * 512, ap->in[19] + l * 512, ap->in[20] + l * 512, ap->in[21] + l * 512,
                                  nullptr, XW + O_CONFP + ((size_t)l * 8 + b) * 30 * 512, b * 2048, ti * 16, 2048, tid); }
#pragma unroll 1
                for (int t = rb; t < 1024; t += rG)
                    sconv_unit((const bf16*)(ws + WS_SB), (const bf16*)(ws + WS_SCC), (const bf16*)(ws + WS_SX), H, ap->in[23] + l * 3 * 512, ap->in[6] + (size_t)l * 128 * 2 * 512,
                               XW + O_SCP + (size_t)l * 8 * 2 * 512, XW + O_SCS + (size_t)l * 128 * 2 * 512, t, tid); }
            PR_T1(3);
            if (!dedic || bid < 16) {
                pg8::Gemm g{(const bf16*)H, (const bf16*)(ws + WS_WBR), MTOK, DM, 2048, 1024, 2048, 16, (long)((const char*)(ws + WS_G) - (const char*)H) - 16l * 128l};
                pg8::ChainOrder S; S.init(64, 4, DM, dedic ? 16 : G, bid);
                EpiBranch3 E{(const bf16*)(ws + WS_GL), ap->in[15] + l * 3072, (bf16*)(ws + WS_MBF)};
                pg8::gemm_phase<EpiBranch3, pg8::ChainOrder, true, true>(lds, g, S, E); } }
        GRID_BAR();
        {   PHASE_BEGIN
            pg8::Gemm g{(const bf16*)H, (const bf16*)(ws + WS_WBR), MTOK, DM, 2048, 1024, 2048, 16, (long)((const char*)(ws + WS_G) - (const char*)H) - 16l * 128l};
            pg8::ChainOrder S; S.init(0, 64, DM, G, bid);
            EpiBranch3 E{(const bf16*)(ws + WS_GL), ap->in[15] + l * 3072, (bf16*)(ws + WS_MBF)};
            pg8::gemm_phase<EpiBranch3, pg8::ChainOrder, true, true>(lds, g, S, E); }
        GRID_BAR();
        {   PHASE_BEGIN
            const float* ada_l = ADA + (size_t)l * NSEQ * NADA;
#if PHASES & 4
            GEMM_PHASE_SPLIT(EpiResid, ws + WS_MBF, ws + WS_WO, DM, 1024, 1024, 1024, 4, XW, (float*)ws, l * NSEQ * NADA + 5 * 1024, 1.0f, 16)
#endif
        }
        GRID_BAR();
        {   PHASE_BEGIN
            const float* ada_l = ADA + (size_t)l * NSEQ * NADA;
            PR_T0(2); rmsmod_phase(XW, XW + (size_t)NPROMPT * DM, nullptr, ap->in[26] + l * DM, ada_l, 6, H, (const float*)(ws + WS_KVB), 4, gw, NGW, lane); PR_T1(2); }
        GRID_BAR();
        {   PHASE_BEGIN
#if PHASES & 2
            GEMM_PHASE(EpiSwiglu, H, ws + WS_W13B, MTOK, 2 * DFF, 1024, 1024, 1024, U)
#ifdef PROBE_UP
            GEMM_PHASE(EpiSwiglu, H, ws + WS_W13B, MTOK, 2 * DFF, 1024, 1024, 1024, U)
#endif
#endif
        }
        GRID_BAR();
        {   PHASE_BEGIN
            const float* ada_l = ADA + (size_t)l * NSEQ * NADA;
#if PHASES & 4
            GEMM_PHASE_SPLIT(EpiResid, U, ws + WS_W2B, DM, DFF, DFF, DFF, 4, XW, (float*)ws, l * NSEQ * NADA + 8 * 1024, 0.5f, DFF / 64)
#endif
            __syncthreads();
            if (l == 0) { if (G >= 128) { if (bid >= 64) convert_layer_main(ap, ws, 1, lds, (bid - 64) * NWAVES + wave, (G - 64) * NWAVES, wave, lane); }
                          else convert_layer_main(ap, ws, 1, lds, gw, NGW, wave, lane); }
        }
        GRID_BAR();
    }
#ifdef PROBE_SYNC
#pragma unroll 1
    for (int q = 0; q < 32; ++q) GRID_BAR();
#endif
    {   PHASE_BEGIN
        PR_T0(2); final_norm_phase(XW, ap->in[30], (const float*)(ws + WS_KVB), 4, gw, NGW, lane); PR_T1(2);
#ifdef PROBE_CAT
        if (bid0 == 0) { const unsigned long long t0_ = __builtin_amdgcn_s_memrealtime(); while (__builtin_amdgcn_s_memrealtime() - t0_ < pr_acc) __builtin_amdgcn_s_sleep(8); }
#endif
    }
}

extern "C" void kernel_launch(void* const* d_in, const int* in_sizes, int n_in, void* d_out, int out_size, void* d_ws, size_t ws_size, hipStream_t stream) {
    static int grid = 0;
    if (grid == 0) {
        if (n_in != 31 || out_size != (int)O_END || ws_size < WS_END) { fprintf(stderr, "kernel_launch: unexpected shapes (n_in %d, out %d, ws %zu)\n", n_in, out_size, ws_size); grid = -1; return; }
        int dev = 0, cus = 0, per_cu = 0;
        if (hipGetDevice(&dev) != hipSuccess || hipDeviceGetAttribute(&cus, hipDeviceAttributeMultiprocessorCount, dev) != hipSuccess) { grid = -1; return; }
        if (hipFuncSetAttribute((const void*)mega_fwd, hipFuncAttributeMaxDynamicSharedMemorySize, LDS_BYTES) != hipSuccess) { fprintf(stderr, "kernel_launch: hipFuncSetAttribute failed\n"); grid = -1; return; }
        if (hipOccupancyMaxActiveBlocksPerMultiprocessor(&per_cu, (const void*)mega_fwd, NTHREADS, LDS_BYTES) != hipSuccess || per_cu < 1) { fprintf(stderr, "kernel_launch: occupancy query failed (%d)\n", per_cu); (void)hipGetLastError(); grid = -1; return; }
        grid = cus * per_cu;
        if (grid < 128) { fprintf(stderr, "kernel_launch: grid %d too small\n", grid); grid = -1; return; }
    }
    if (grid < 0) return;
    Args a{};
    for (int i = 0; i < 31; ++i) a.in[i] = (const float*)d_in[i];
    a.out = (float*)d_out; a.ws = (unsigned char*)d_ws;
    if (hipMemsetAsync((char*)d_ws + WS_BAR, 0, WS_BAR_BYTES, stream) != hipSuccess) { fprintf(stderr, "kernel_launch: memset failed\n"); return; }
    void* args[] = {&a};
    hipError_t e = hipLaunchCooperativeKernel((const void*)mega_fwd, dim3(grid), dim3(NTHREADS), args, LDS_BYTES, stream);
    if (e != hipSuccess) fprintf(stderr, "kernel_launch: cooperative launch failed: %s (grid %d)\n", hipGetErrorString(e), grid);
}
```

```cpp
#include <hip/hip_runtime.h>
#include <hip/hip_cooperative_groups.h>
#include <cstdio>
#include <cstdint>
namespace cg = cooperative_groups;
namespace pg8 {
#define PG8_LAS __attribute__((address_space(3)))
typedef unsigned short bf16_t;
typedef short bf16x8 __attribute__((ext_vector_type(8)));
typedef float f32x4 __attribute__((ext_vector_type(4)));
typedef unsigned u32x4 __attribute__((ext_vector_type(4)));
constexpr int BM = 256, BK = 64, HALF = 128, HTB = HALF * BK * 2  , STAGE_BYTES = 8 * HTB, NXCD = 8, WGM = 8;

__host__ __device__ __forceinline__ int lds_byte(int r, int c) { const int st = (r >> 4) * 2 + (c >> 5), rr = r & 15, cc = c & 31, ob = rr * 64 + cc * 2; return st * 1024 + (ob ^ (((ob >> 9) & 1) << 5)); }
__host__ __device__ __forceinline__ void stage_rc(int b, int& R, int& C) { const int st = b / 1024, sb = b % 1024, swz = sb ^ (((sb >> 9) & 1) << 5); R = (st >> 1) * 16 + swz / 64; C = (st & 1) * 32 + (swz % 64) / 2; }
__host__ __device__ __forceinline__ int perm32(int rho) { const int n = rho >> 4, i = rho & 15; return 8 * (i >> 2) + 4 * n + (i & 3); }

struct Unit { int pm, pn, kb, nk, seg; };
struct Gemm { const bf16_t* A; const bf16_t* Bt; int M, N, K, lda, ldb; int tsw; long adelta; };

struct StaticOrder {
    int nM, nN, nwg, G, c, nt;
    __host__ __device__ __forceinline__ void init(int M, int N, int G_, int c_, int K) { nM = M / BM; nN = N / BM; nwg = nM * nN; G = G_; c = c_; nt = K / BK; }
    __host__ __device__ __forceinline__ void map(int wgid, int& pm, int& pn) const {
        { const int q = nwg / NXCD, r = nwg % NXCD, xcd = wgid % NXCD, off = wgid / NXCD; wgid = (xcd < r ? xcd * (q + 1) : r * (q + 1) + (xcd - r) * q) + off; }
        const int nig = WGM * nN, gid = wgid / nig, fm = gid * WGM, gsz = (nM - fm) < WGM ? (nM - fm) : WGM;
        pm = fm + ((wgid % nig) % gsz); pn = (wgid % nig) / gsz; }
    __host__ __device__ __forceinline__ bool next(int i, Unit& u) const {
        const long L = (long)i * G + c; const bool ok = L < nwg; int pm, pn; map(ok ? (int)L : 0, pm, pn);
        u.pm = pm; u.pn = pn; u.kb = 0; u.nk = nt; u.seg = 0; return ok; }
    __device__ __forceinline__ void a_ready(const Unit&) const {}
    __device__ __forceinline__ void done(const Unit&) const {}
};
struct ChainOrder {
    StaticOrder P; int pm0;
    __host__ __device__ __forceinline__ void init(int pm0_, int nMs, int N, int G_, int c_) { P.init(nMs * BM, N, G_, c_, 2048); pm0 = pm0_; }
    __host__ __device__ __forceinline__ bool next(int i, Unit& u) const {
        const int ti = i / 3, seg = i - 3 * ti; const long L = (long)ti * P.G + P.c; const bool ok = L < P.nwg && P.c >= 0; int pm, pn; P.map(ok ? (int)L : 0, pm, pn);
        u.pm = pm0 + pm; u.pn = pn; u.kb = seg * 8; u.nk = seg == 2 ? 16 : 8; u.seg = seg; return ok; }
    __device__ __forceinline__ void a_ready(const Unit&) const {}
    __device__ __forceinline__ void done(const Unit&) const {}
};
struct WinOrder {
    StaticOrder P;
    __host__ __device__ __forceinline__ void init(int M, int G_, int c_, int K) { P.init(M, 33 * BM, G_, c_, K); }
    __host__ __device__ __forceinline__ bool next(int i, Unit& u) const {
        const long L0 = (long)i * P.G + P.c; const bool isA = L0 < P.nwg; const long j = L0 - P.nwg; const bool isB = !isA && j < 60;
        int pm, pn; P.map(isA ? (int)L0 : 0, pm, pn); const int jb = isB ? (int)j : 0;
        u.pm = isA ? pm : (jb < 32 ? jb : jb + 8); u.pn = isA ? pn : 33; u.kb = 0; u.nk = P.nt; u.seg = 0; return isA || isB; }
    __device__ __forceinline__ void a_ready(const Unit&) const {}
    __device__ __forceinline__ void done(const Unit&) const {}
};
struct OneOrder {
    int pm, pn, nt;
    __host__ __device__ __forceinline__ bool next(int i, Unit& u) const { u.pm = pm; u.pn = pn; u.kb = 0; u.nk = nt; u.seg = 0; return i == 0; }
    __device__ __forceinline__ void a_ready(const Unit&) const {}
    __device__ __forceinline__ void done(const Unit&) const {}
};
struct SplitOrder {
    StaticOrder P; int S, nsub;
    __host__ __device__ __forceinline__ void init(int Mfull, int N, int G_, int c_, int K, int S_) { P.init(Mfull, N, G_, c_, K); S = S_; nsub = (P.nM - 64) * P.nN * S_; P.nM = 64; P.nwg = 64 * P.nN; }
    __host__ __device__ __forceinline__ bool next(int i, Unit& u) const {
        const bool special = (P.G == P.nwg) && (nsub <= P.G);
        const long L0 = (long)i * P.G + P.c; const bool hs = P.c < nsub;
        const bool isP = special ? (hs ? i == 1 : i == 0) : (L0 < P.nwg); const long Ls = special ? (long)P.c : L0 - P.nwg; const bool isS = special ? (hs && i == 0) : (!isP && Ls >= 0 && Ls < nsub);
        int ppm, ppn; P.map(isP ? (special ? P.c : (int)L0) : 0, ppm, ppn);
        const int L = isS ? (int)Ls : 0, tile = L / S, ks = L - tile * S, hp = P.nt / 2, q = hp / S, r = hp - q * S, spm = 64 + tile / P.nN, spn = tile - (tile / P.nN) * P.nN;
        const int skb = 2 * (ks * q + (ks < r ? ks : r)), snk = 2 * (q + (ks < r ? 1 : 0));
        u.pm = isP ? ppm : spm; u.pn = isP ? ppn : spn; u.nk = isP ? P.nt : snk; u.kb = isP ? 0 : skb; u.seg = isP ? 0 : ks; return isP || isS; }
    __device__ __forceinline__ void a_ready(const Unit&) const {}
    __device__ __forceinline__ void done(const Unit&) const {}
};


__device__ __forceinline__ unsigned cvt_pk_bf16(float lo, float hi) { unsigned r; asm volatile("v_cvt_pk_bf16_f32 %0, %1, %2" : "=v"(r) : "v"(lo), "v"(hi)); return r; }
typedef float f32x2 __attribute__((ext_vector_type(2)));

template <class Epi, class Sched, bool ALIGN_EPI = false, bool SP2 = false>
__device__ __forceinline__ void gemm_phase(PG8_LAS unsigned char* lds, const Gemm g, const Sched& S, const Epi& E) {
    int tid_ = threadIdx.x; asm volatile("" : "+v"(tid_)); const int tid = tid_, wid = __builtin_amdgcn_readfirstlane(tid >> 6), lane = tid & 63, wr = wid >> 2, wc = wid & 3, fr = lane & 15, fq = lane >> 4;
    unsigned voffA[2], voffB[2];
#pragma unroll
    for (int i = 0; i < 2; ++i) { int R, C; stage_rc(tid * 16 + i * 8192, R, C); const int Rb = Epi::PERM ? ((R & ~31) + perm32(R & 31)) : R;
        voffA[i] = (unsigned)(R * g.lda + C) * 2u; voffB[i] = (unsigned)(Rb * g.ldb + C) * 2u; }
    const size_t kstep = (size_t)(BK * 2);
    const size_t hstepA = (size_t)HALF * g.lda * 2, hstepB = (size_t)HALF * g.ldb * 2;
    const size_t tstepA = 2 * hstepA, tstepB = 2 * hstepB;
    const unsigned ldsw = (unsigned)wid * 1024u;
    const int aoff = lds_byte(wr * 64 + fr, fq * 8), boff = lds_byte(wc * 32 + fr, fq * 8);
#define PG8_SA(b, h) (((b) * 2 + (h)) * HTB)
#define PG8_SB(b, h) ((4 + (b) * 2 + (h)) * HTB)
#define PG8_STAGE(bufoff, gbase, voff) do { _Pragma("unroll") for (int _i = 0; _i < 2; ++_i) \
        __builtin_amdgcn_global_load_lds((const unsigned*)((const char*)(gbase) + (voff)[_i]), (PG8_LAS unsigned*)(lds + (bufoff) + ldsw + _i * 8192), 16, 0, 0); } while (0)
#define PG8_LDA(dst, b, h) do { _Pragma("unroll") for (int m = 0; m < 4; ++m) _Pragma("unroll") for (int k = 0; k < 2; ++k) dst[m][k] = *(const PG8_LAS bf16x8*)(lds + PG8_SA(b, h) + aoff + m * 2048 + k * 1024); } while (0)
#define PG8_LDB(dst, b, h) do { _Pragma("unroll") for (int n = 0; n < 2; ++n) _Pragma("unroll") for (int k = 0; k < 2; ++k) dst[n][k] = *(const PG8_LAS bf16x8*)(lds + PG8_SB(b, h) + boff + n * 2048 + k * 1024); } while (0)
#define PG8_MMA(ai, bj, At, Bt) do { __builtin_amdgcn_s_setprio(1); _Pragma("unroll") for (int m = 0; m < 4; ++m) _Pragma("unroll") for (int n = 0; n < 2; ++n) _Pragma("unroll") for (int k = 0; k < 2; ++k) \
        acc[ai][bj][m][n] = __builtin_amdgcn_mfma_f32_16x16x32_bf16(Bt[n][k], At[m][k], acc[ai][bj][m][n], 0, 0, 0); __builtin_amdgcn_s_setprio(0); } while (0)
#define PG8_WAIT_V(n) asm volatile("s_waitcnt vmcnt(" #n ")" ::: "memory")
#define PG8_WAIT_L(n) asm volatile("s_waitcnt lgkmcnt(" #n ")" ::: "memory")
#define PG8_BAR __builtin_amdgcn_s_barrier()
#define PG8_SCHED __builtin_amdgcn_sched_barrier(0)
    Unit cur, nxt; int ui = 0;
    if (!S.next(0, cur)) return;
    f32x4 acc[2][2][4][2];
    float zf_ = 0.f; asm volatile("" : "+v"(zf_));
#pragma unroll
    for (int a = 0; a < 2; ++a)
#pragma unroll
        for (int b = 0; b < 2; ++b)
#pragma unroll
            for (int m = 0; m < 4; ++m)
#pragma unroll
                for (int n = 0; n < 2; ++n) acc[a][b][m][n] = (f32x4){zf_, zf_, zf_, zf_};
    bf16x8 At[4][2], B0[2][2], B1[2][2];
    const int tsw = g.tsw; const long adelta = g.adelta;
    const char* cA = (const char*)g.A + (size_t)cur.pm * tstepA + (size_t)cur.kb * kstep + (cur.kb >= tsw ? adelta : 0l); const char* cB = (const char*)g.Bt + (size_t)cur.pn * tstepB + (size_t)cur.kb * kstep;
    S.a_ready(cur);
    if constexpr (SP2) {
        PG8_STAGE(PG8_SB(0, 0), cB, voffB); PG8_STAGE(PG8_SB(0, 1), cB + hstepB, voffB); PG8_STAGE(PG8_SA(0, 0), cA, voffA); PG8_STAGE(PG8_SA(0, 1), cA + hstepA, voffA);
        if (wr == 1) PG8_BAR;
        PG8_WAIT_V(2); PG8_BAR;
        PG8_STAGE(PG8_SB(1, 0), cB + kstep, voffB); PG8_STAGE(PG8_SA(1, 0), cA + kstep, voffA); PG8_STAGE(PG8_SB(1, 1), cB + hstepB + kstep, voffB);
        PG8_WAIT_V(6); PG8_BAR;
    } else {
        PG8_STAGE(PG8_SB(0, 0), cB, voffB); PG8_STAGE(PG8_SA(0, 0), cA, voffA); PG8_STAGE(PG8_SB(0, 1), cB + hstepB, voffB); PG8_STAGE(PG8_SA(0, 1), cA + hstepA, voffA);
        if (wr == 1) PG8_BAR;
        PG8_WAIT_V(4); PG8_BAR;
        PG8_STAGE(PG8_SB(1, 0), cB + kstep, voffB); PG8_STAGE(PG8_SA(1, 0), cA + kstep, voffA); PG8_STAGE(PG8_SB(1, 1), cB + hstepB + kstep, voffB);
        PG8_WAIT_V(6); PG8_BAR;
    }
    for (;;) {
        const bool has_next = S.next(ui + 1, nxt);
        const char* nA = has_next ? (const char*)g.A + (size_t)nxt.pm * tstepA + (size_t)nxt.kb * kstep + (nxt.kb >= tsw ? adelta : 0l) : cA; const char* nB = has_next ? (const char*)g.Bt + (size_t)nxt.pn * tstepB + (size_t)nxt.kb * kstep : cB;
        const int nt = cur.nk;
        for (int t = 0; t < nt; t += 2) {
            const bool last = (t == nt - 2);
            const char* a1 = cA + (size_t)(t + 1) * kstep;
            const char* a2 = last ? nA : cA + (size_t)(t + 2) * kstep; const char* b2 = last ? nB : cB + (size_t)(t + 2) * kstep;
            const char* a3 = a2 + kstep; const char* b3 = b2 + kstep;
            if (last && has_next) S.a_ready(nxt);
            if constexpr (SP2) {
            PG8_LDB(B0, 0, 0); PG8_LDB(B1, 0, 1); PG8_SCHED; PG8_LDA(At, 0, 0); PG8_STAGE(PG8_SA(1, 1), a1 + hstepA, voffA);
            PG8_WAIT_V(8); PG8_WAIT_L(0); PG8_BAR; PG8_MMA(0, 0, At, B0); PG8_MMA(0, 1, At, B1); PG8_BAR; PG8_SCHED;
            PG8_LDA(At, 0, 1); PG8_STAGE(PG8_SB(0, 0), b2, voffB); PG8_STAGE(PG8_SB(0, 1), b2 + hstepB, voffB); PG8_STAGE(PG8_SA(0, 0), a2, voffA);
            PG8_WAIT_V(8); PG8_WAIT_L(0); PG8_BAR; PG8_MMA(1, 0, At, B0); PG8_MMA(1, 1, At, B1); PG8_BAR; PG8_SCHED;
            PG8_LDB(B0, 1, 0); PG8_LDB(B1, 1, 1); PG8_SCHED; PG8_LDA(At, 1, 0); PG8_STAGE(PG8_SA(0, 1), a2 + hstepA, voffA);
            PG8_WAIT_V(8); PG8_WAIT_L(0); PG8_BAR; PG8_MMA(0, 0, At, B0); PG8_MMA(0, 1, At, B1); PG8_BAR; PG8_SCHED;
            PG8_LDA(At, 1, 1); PG8_STAGE(PG8_SB(1, 0), b3, voffB); PG8_STAGE(PG8_SB(1, 1), b3 + hstepB, voffB); PG8_STAGE(PG8_SA(1, 0), a3, voffA);
            PG8_WAIT_V(8); PG8_WAIT_L(0); PG8_BAR; PG8_MMA(1, 0, At, B0); PG8_MMA(1, 1, At, B1); PG8_BAR; PG8_SCHED;
            } else {
            PG8_LDB(B0, 0, 0); PG8_SCHED; PG8_LDA(At, 0, 0); PG8_STAGE(PG8_SA(1, 1), a1 + hstepA, voffA);
            PG8_WAIT_L(8); PG8_BAR; PG8_WAIT_L(0); PG8_MMA(0, 0, At, B0); PG8_BAR; PG8_SCHED;
            PG8_LDB(B1, 0, 1); PG8_STAGE(PG8_SB(0, 0), b2, voffB);
            PG8_BAR; PG8_WAIT_L(0); PG8_MMA(0, 1, At, B1); PG8_BAR;
            PG8_LDA(At, 0, 1); PG8_STAGE(PG8_SA(0, 0), a2, voffA);
            PG8_BAR; PG8_WAIT_L(0); PG8_MMA(1, 0, At, B0); PG8_BAR; PG8_SCHED;
            PG8_STAGE(PG8_SB(0, 1), b2 + hstepB, voffB);
            PG8_WAIT_V(6); PG8_BAR; PG8_MMA(1, 1, At, B1); PG8_BAR;
            PG8_LDB(B0, 1, 0); PG8_SCHED; PG8_LDA(At, 1, 0); PG8_STAGE(PG8_SA(0, 1), a2 + hstepA, voffA);
            PG8_WAIT_L(8); PG8_BAR; PG8_WAIT_L(0); PG8_MMA(0, 0, At, B0); PG8_BAR; PG8_SCHED;
            PG8_LDB(B1, 1, 1); PG8_STAGE(PG8_SB(1, 0), b3, voffB);
            PG8_BAR; PG8_WAIT_L(0); PG8_MMA(0, 1, At, B1); PG8_BAR;
            PG8_LDA(At, 1, 1); PG8_STAGE(PG8_SA(1, 0), a3, voffA);
            PG8_BAR; PG8_WAIT_L(0); PG8_MMA(1, 0, At, B0); PG8_BAR; PG8_SCHED;
            PG8_STAGE(PG8_SB(1, 1), b3 + hstepB, voffB);
            PG8_WAIT_V(6); PG8_BAR; PG8_MMA(1, 1, At, B1); PG8_BAR;
            }
        }
        if constexpr (ALIGN_EPI) { if (wr == 0) PG8_BAR; }
        if constexpr (!Epi::AFTER_DRAIN) { E(acc, cur, wr, wc, fr, fq); S.done(cur); }
        if (!has_next) break;
        if (!(Epi::CHAIN && cur.seg < 2)) {
#pragma unroll
        for (int a = 0; a < 2; ++a)
#pragma unroll
            for (int b = 0; b < 2; ++b)
#pragma unroll
                for (int m = 0; m < 4; ++m)
#pragma unroll
                    for (int n = 0; n < 2; ++n) acc[a][b][m][n] = (f32x4){0.f, 0.f, 0.f, 0.f};
        }
        cur = nxt; cA = nA; cB = nB; ++ui;
        if constexpr (ALIGN_EPI) { if (wr == 1) PG8_BAR; }
    }
    PG8_WAIT_V(0);
    if constexpr (!ALIGN_EPI) { if (wr == 0) PG8_BAR; }
    PG8_BAR;
    if constexpr (Epi::AFTER_DRAIN) { E.fused(acc, cur, wr, wc, fr, fq, lds, wid, lane); S.done(cur); }
#undef PG8_SA
#undef PG8_SB
#undef PG8_STAGE
#undef PG8_LDA
#undef PG8_LDB
#undef PG8_MMA
#undef PG8_WAIT_V
#undef PG8_WAIT_L
#undef PG8_BAR
#undef PG8_SCHED
}
}
#ifndef PHASES
#define PHASES 0xFFFF
#endif

#define LAS __attribute__((address_space(3)))
typedef unsigned short bf16;
typedef float f32x4 __attribute__((ext_vector_type(4)));
typedef short bf16x8 __attribute__((ext_vector_type(8)));
typedef unsigned u32x4 __attribute__((ext_vector_type(4)));
typedef unsigned u32x2 __attribute__((ext_vector_type(2)));

constexpr int NPROMPT = 8 * 2048, NSAMPLE = 128 * 8, MTOK = NPROMPT + NSAMPLE;
constexpr int DM = 1024, DFF = 2816, NADA = 9216, NSEQ = 136, INCOLS = 8704;
constexpr int NTHREADS = 512, NWAVES = 8;

constexpr size_t MiB = 1u << 20;
constexpr size_t WS_ADA = 0, WS_CSIL = 10 * MiB, WS_ROPE = 11 * MiB;
constexpr size_t WS_W13A = 12 * MiB, WS_W2A = 23 * MiB, WS_W13B = 29 * MiB, WS_W2B = 40 * MiB, WS_WIN = 46 * MiB;
constexpr size_t WS_WBR = 63 * MiB, WS_WO = 67 * MiB;
constexpr size_t WS_H = 69 * MiB;
constexpr size_t WS_Z = 103 * MiB;
constexpr size_t WS_Q = WS_Z, WS_K = WS_Z + 17 * MiB, WS_V = WS_Z + 34 * MiB, WS_G = WS_Z + 68 * MiB;
constexpr size_t WS_CA = WS_Z + 102 * MiB, WS_CB = WS_Z + 119 * MiB, WS_SB = WS_Z + 136 * MiB, WS_SCC = WS_Z + 153 * MiB, WS_SX = WS_Z + 170 * MiB;
constexpr size_t WS_GL = WS_Z + 187 * MiB;
constexpr size_t WS_KVB = WS_GL + 102 * MiB;
constexpr size_t WS_BAR = WS_KVB + 32 * MiB;
constexpr size_t WS_BAR_BYTES = 65536;
constexpr size_t WS_END = WS_BAR + WS_BAR_BYTES;
constexpr size_t WS_SCB = WS_SX;
constexpr size_t WS_U = WS_Z;
constexpr size_t WS_WADA = WS_Z;
constexpr size_t WS_M32 = WS_CA;
constexpr size_t WS_MBF = WS_V;

constexpr size_t O_Y = 0, O_RETP = 17825792, O_RETS = 18874368, O_CONFP = 35651584, O_CONFS = 35897344, O_SCP = 39829504, O_SCS = 39845888, O_END = 40108032;

constexpr int LDS_BYTES = 147456;

__device__ __forceinline__ unsigned f2bf(float f) { unsigned u = __builtin_bit_cast(unsigned, f); return (u + 0x7fffu + ((u >> 16) & 1u)) >> 16; }
__device__ __forceinline__ unsigned pk2(float lo, float hi) { return f2bf(lo) | (f2bf(hi) << 16); }
__device__ __forceinline__ float bf2f(unsigned b) { return __builtin_bit_cast(float, b << 16); }
__device__ __forceinline__ float bflo(unsigned w) { return __builtin_bit_cast(float, w << 16); }
__device__ __forceinline__ float bfhi(unsigned w) { return __builtin_bit_cast(float, w & 0xffff0000u); }
__device__ __forceinline__ float sigmoidf_(float x) { return __builtin_amdgcn_rcpf(1.0f + __expf(-x)); }
__device__ __forceinline__ float siluf_(float x) { return x * sigmoidf_(x); }
__device__ __forceinline__ int seq_of_row(int row) { return row < NPROMPT ? (row >> 11) : 8 + ((row - NPROMPT) >> 3); }
__device__ __forceinline__ float wave_sum(float v) {
#pragma unroll
    for (int o = 1; o < 64; o <<= 1) v += __shfl_xor(v, o);
    return v;
}
__device__ __forceinline__ float lgamma_h(int h) {
    float r = -0.0317486983145803f;
    r = h == 1 ? -0.015748356968139168f : r; r = h == 2 ? -0.007843177461025893f : r; r = h == 3 ? -0.003913899321136329f : r;
    r = h == 4 ? -0.0019550348358033506f : r; r = h == 5 ? -0.0009770396478266127f : r; r = h == 6 ? -0.0004884004981088745f : r; r = h == 7 ? -0.0002441704321739145f : r;
    return r;
}

using pg8::Unit;
struct EpiSwiglu {
    static constexpr bool PERM = true, AFTER_DRAIN = false, CHAIN = false;
    bf16* U;
    __device__ __forceinline__ void operator()(const f32x4 (&acc)[2][2][4][2], const Unit& u, int wr, int wc, int fr, int fq) const {
        const int row0 = u.pm * 256 + wr * 64 + fr, ucol0 = u.pn * 128 + wc * 16 + 4 * fq;
#pragma unroll
        for (int ai = 0; ai < 2; ++ai)
#pragma unroll
            for (int m = 0; m < 4; ++m) { bf16* rowp = U + (size_t)(row0 + ai * 128 + m * 16) * DFF + ucol0;
#pragma unroll
                for (int bj = 0; bj < 2; ++bj) { const f32x4 v0 = acc[ai][bj][m][0], v1 = acc[ai][bj][m][1];
                    u32x2 w; w.x = pk2(siluf_(v0[0]) * v1[0], siluf_(v0[1]) * v1[1]); w.y = pk2(siluf_(v0[2]) * v1[2], siluf_(v0[3]) * v1[3]);
                    *(u32x2*)(rowp + bj * 64) = w; } }
    }
};
struct EpiResid {
    static constexpr bool PERM = false, AFTER_DRAIN = false, CHAIN = false;
    float* x; float* wsf; int goff; float coef; int nt_full; long xoff;
    __device__ __forceinline__ void operator()(const f32x4 (&acc)[2][2][4][2], const Unit& u, int wr, int wc, int fr, int fq) const {
        const int col0 = u.pn * 256 + wc * 32 + 4 * fq; const bool part = u.nk != nt_full; const int ksub = u.seg;
#pragma unroll
        for (int ai = 0; ai < 2; ++ai)
#pragma unroll
            for (int m = 0; m < 4; ++m) { const int row = u.pm * 256 + ai * 128 + wr * 64 + m * 16 + fr; const float* gp = wsf + goff + (size_t)seq_of_row(row) * NADA + col0; float* xp = x + (size_t)row * DM + col0;
#pragma unroll
                for (int bj = 0; bj < 2; ++bj)
#pragma unroll
                    for (int n = 0; n < 2; ++n) { const int c = bj * 128 + n * 16; const f32x4 g4 = *(const f32x4*)(gp + c); const f32x4 v = acc[ai][bj][m][n] * g4 * coef;
                        if (part) { *(f32x4*)(wsf + WS_KVB / 4 + ((size_t)ksub * NSAMPLE + (row - NPROMPT)) * DM + col0 + c) = v; }
                        else { const f32x4 xv = *(const f32x4*)(xp + xoff + c); *(f32x4*)(xp + c) = xv + v; } }
                asm volatile("" ::: "memory"); }
    }
};
struct EpiBranch3 {
    static constexpr bool PERM = false, AFTER_DRAIN = false, CHAIN = true;
    const bf16* GL; const float* bgate; bf16* MBF;
    __device__ __forceinline__ void operator()(f32x4 (&acc)[2][2][4][2], const Unit& u, int wr, int wc, int fr, int fq) const {
        const int col0 = u.pn * 256 + wc * 32 + 4 * fq; const int seg = u.seg;
        const int ba = seg == 0 ? 1024 : (seg == 1 ? 2048 : 0), bb = seg == 0 ? 2048 : 0; const float fb = seg == 2 ? 0.f : 1.f;
#pragma unroll
        for (int ai = 0; ai < 2; ++ai)
#pragma unroll
            for (int m = 0; m < 4; ++m) { const int row = u.pm * 256 + ai * 128 + wr * 64 + m * 16 + fr; const bf16* gl = GL + (size_t)row * 3072;
#pragma unroll
                for (int bj = 0; bj < 2; ++bj)
#pragma unroll
                    for (int n = 0; n < 2; ++n) { const int c = col0 + bj * 128 + n * 16;
                        const u32x2 wa = *(const u32x2*)(gl + ba + c), wb = *(const u32x2*)(gl + bb + c); const f32x4 za = *(const f32x4*)(bgate + ba + c), zb = *(const f32x4*)(bgate + bb + c);
                        f32x4 r;
                        r[0] = (1.0f + fb * __expf(-(bflo(wb.x) + zb[0]))) * __builtin_amdgcn_rcpf(1.0f + __expf(-(bflo(wa.x) + za[0])));
                        r[1] = (1.0f + fb * __expf(-(bfhi(wb.x) + zb[1]))) * __builtin_amdgcn_rcpf(1.0f + __expf(-(bfhi(wa.x) + za[1])));
                        r[2] = (1.0f + fb * __expf(-(bflo(wb.y) + zb[2]))) * __builtin_amdgcn_rcpf(1.0f + __expf(-(bflo(wa.y) + za[2])));
                        r[3] = (1.0f + fb * __expf(-(bfhi(wb.y) + zb[3]))) * __builtin_amdgcn_rcpf(1.0f + __expf(-(bfhi(wa.y) + za[3])));
                        const f32x4 v = acc[ai][bj][m][n] * r; acc[ai][bj][m][n] = v;
                        if (seg == 2) { u32x2 w; w.x = pk2(v[0], v[1]); w.y = pk2(v[2], v[3]); *(u32x2*)(MBF + (size_t)row * DM + c) = w; }
                        asm volatile("" ::: "memory"); } }
    }
};
struct EpiWin {
    static constexpr bool PERM = true, AFTER_DRAIN = false, CHAIN = false;
    unsigned char* ws;
    __device__ __forceinline__ void operator()(const f32x4 (&acc)[2][2][4][2], const Unit& u, int wr, int wc, int fr, int fq) const {
        const int colt = u.pn * 256; size_t off; int ld, c0, kind = 0;
        if (colt < 512) { off = WS_Q; ld = 512; c0 = colt; }
        else if (colt < 1024) { off = WS_K; ld = 512; c0 = colt - 512; }
        else if (colt < 2048) { off = WS_V; ld = 1024; c0 = colt - 1024; }
        else if (colt < 3072) { off = WS_G; ld = 1024; c0 = colt - 2048; }
        else if (colt < 4096) { off = WS_CA; ld = 512; c0 = (colt - 3072) >> 1; kind = 1; }
        else if (colt < 4608) { off = WS_SB; ld = 512; c0 = colt - 4096; }
        else if (colt < 5632) { off = WS_SCC; ld = 512; c0 = (colt - 4608) >> 1; kind = 2; }
        else { off = WS_GL; ld = 3072; c0 = colt - 5632; }
        bf16* base = (bf16*)(ws + off);
        const int row0 = u.pm * 256 + wr * 64 + fr;
        if (kind == 0) {
            const int col0 = c0 + wc * 32 + 8 * fq;
#pragma unroll
            for (int ai = 0; ai < 2; ++ai)
#pragma unroll
                for (int m = 0; m < 4; ++m) { bf16* rowp = base + (size_t)(row0 + ai * 128 + m * 16) * ld + col0;
#pragma unroll
                    for (int bj = 0; bj < 2; ++bj) { const f32x4 v0 = acc[ai][bj][m][0], v1 = acc[ai][bj][m][1];
                        u32x4 w; w.x = pk2(v0[0], v0[1]); w.y = pk2(v0[2], v0[3]); w.z = pk2(v1[0], v1[1]); w.w = pk2(v1[2], v1[3]);
                        *(u32x4*)(rowp + bj * 128) = w; } }
        } else {
            const int col0 = c0 + wc * 16 + 4 * fq;
#pragma unroll
            for (int ai = 0; ai < 2; ++ai)
#pragma unroll
                for (int m = 0; m < 4; ++m) { bf16* rowp = base + (size_t)(row0 + ai * 128 + m * 16) * ld + col0;
#pragma unroll
                    for (int bj = 0; bj < 2; ++bj) { const f32x4 v0 = acc[ai][bj][m][0], v1 = acc[ai][bj][m][1];
                        f32x4 o;
                        if (kind == 1) { o[0] = v0[0] * sigmoidf_(v1[0]); o[1] = v0[1] * sigmoidf_(v1[1]); o[2] = v0[2] * sigmoidf_(v1[2]); o[3] = v0[3] * sigmoidf_(v1[3]); }
                        else o = v0 * v1;
                        u32x2 w; w.x = pk2(o[0], o[1]); w.y = pk2(o[2], o[3]); *(u32x2*)(rowp + bj * 64) = w; } }
        }
    }
};
struct EpiAda {
    static constexpr bool PERM = false, AFTER_DRAIN = false, CHAIN = false;
    float* ADA; const float* bada;
    __device__ __forceinline__ void operator()(const f32x4 (&acc)[2][2][4][2], const Unit& u, int wr, int wc, int fr, int fq) const {
        const int l = u.pn / 36, col0 = (u.pn - l * 36) * 256 + wc * 32 + 4 * fq;
#pragma unroll
        for (int ai = 0; ai < 2; ++ai)
#pragma unroll
            for (int m = 0; m < 4; ++m) { const int row = ai * 128 + wr * 64 + m * 16 + fr;
                if (row < NSEQ) {
#pragma unroll
                    for (int bj = 0; bj < 2; ++bj)
#pragma unroll
                        for (int n = 0; n < 2; ++n) { const int c = col0 + bj * 128 + n * 16;
                            *(f32x4*)(ADA + ((size_t)l * NSEQ + row) * NADA + c) = acc[ai][bj][m][n] + *(const f32x4*)(bada + (size_t)l * NADA + c); } } }
    }
};

struct ConvD { const float* W; bf16* WT; int N, ldk, mode, roff, r; };
__device__ __forceinline__ void conv_load(float (&v)[32], const ConvD& d, int lane) {
    const int nblk = d.N / 32, kb = d.r / nblk, nb = d.r - kb * nblk; const float* p = d.W + (size_t)(64 * kb + (lane >> 5)) * d.N + 32 * nb + (lane & 31);
#pragma unroll
    for (int i = 0; i < 32; ++i) v[i] = p[(size_t)(2 * i) * d.N];
}
__device__ __forceinline__ void conv_store(const float (&v)[32], const ConvD& d, LAS float* scr, int lane) {
    const int nblk = d.N / 32, kb = d.r / nblk, nb = d.r - kb * nblk, k0 = 64 * kb, n0 = 32 * nb;
#pragma unroll
    for (int i = 0; i < 32; ++i) scr[(2 * i + (lane >> 5)) * 33 + (lane & 31)] = v[i];
    asm volatile("s_waitcnt lgkmcnt(0)" ::: "memory");
    const int c = lane & 7;
#pragma unroll
    for (int j = 0; j < 4; ++j) { const int n = (lane >> 3) + 8 * j; const LAS float* s = scr + (8 * c) * 33 + n; const int ng = n0 + n;
        int row = d.mode == 0 ? d.roff + ng : (((ng >> 2) << 3) + (d.mode == 2 ? 4 : 0) + (ng & 3));
        if (d.mode == 3) { row = ng; const int base = (ng >= 3072 && ng < 4096) ? 3072 : ((ng >= 4608 && ng < 5632) ? 4608 : -1);
            if (base >= 0) { const int loc = ng - base; row = base + (((loc & 511) >> 2) << 3) + ((loc >> 9) << 2) + (loc & 3); } }
        u32x4 o; o.x = pk2(s[0 * 33], s[1 * 33]); o.y = pk2(s[2 * 33], s[3 * 33]); o.z = pk2(s[4 * 33], s[5 * 33]); o.w = pk2(s[6 * 33], s[7 * 33]);
        *(u32x4*)(d.WT + (size_t)row * d.ldk + k0 + 8 * c) = o; }
    asm volatile("s_waitcnt lgkmcnt(0)" ::: "memory");
}

struct Args { const float* in[31]; float* out; unsigned char* ws; };
typedef const __attribute__((address_space(4))) Args* ArgsP;

#define CDESC(Wp, Kk, Nn, WTp, ldk_, mode_, roff_) { const int cnt_ = ((Kk) / 64) * ((Nn) / 32); if (r < cnt_) { d.W = (Wp); d.WT = (WTp); d.N = (Nn); d.ldk = (ldk_); d.mode = (mode_); d.roff = (roff_); d.r = r; return d; } r -= cnt_; }
constexpr int LAYER_CONV_MAIN = 5 * 1408 + 4352 + 512 + 256 + 256 + 512;
__device__ __forceinline__ ConvD conv_desc_main(ArgsP ap, unsigned char* ws, int l, int it) {
    ConvD d; int r = it; const size_t ffo = (size_t)l * DM * DFF;
    CDESC(ap->in[10] + ffo, 1024, 2816, (bf16*)(ws + WS_W13A), 1024, 1, 0)
    CDESC(ap->in[11] + ffo, 1024, 2816, (bf16*)(ws + WS_W13A), 1024, 2, 0)
    CDESC(ap->in[12] + ffo, 2816, 1024, (bf16*)(ws + WS_W2A), 2816, 0, 0)
    CDESC(ap->in[27] + ffo, 1024, 2816, (bf16*)(ws + WS_W13B), 1024, 1, 0)
    CDESC(ap->in[28] + ffo, 1024, 2816, (bf16*)(ws + WS_W13B), 1024, 2, 0)
    CDESC(ap->in[14] + (size_t)l * DM * INCOLS, 1024, 8704, (bf16*)(ws + WS_WIN), 1024, 3, 0)
    CDESC(ap->in[17] + (size_t)l * 1024 * 1024, 1024, 1024, (bf16*)(ws + WS_WBR) + 1024, 2048, 0, 0)
    CDESC(ap->in[22] + (size_t)l * 512 * 1024, 512, 1024, (bf16*)(ws + WS_WBR), 2048, 0, 0)
    CDESC(ap->in[24] + (size_t)l * 512 * 1024, 512, 1024, (bf16*)(ws + WS_WBR) + 512, 2048, 0, 0)
    d.W = ap->in[25] + (size_t)l * 1024 * 1024; d.WT = (bf16*)(ws + WS_WO); d.N = 1024; d.ldk = 1024; d.mode = 0; d.roff = 0; d.r = r; return d;
}
__device__ __forceinline__ ConvD conv_desc_w2b(ArgsP ap, unsigned char* ws, int l, int it) {
    ConvD d; d.W = ap->in[29] + (size_t)l * DM * DFF; d.WT = (bf16*)(ws + WS_W2B); d.N = 1024; d.ldk = 2816; d.mode = 0; d.roff = 0; d.r = it; return d; }
__device__ __forceinline__ ConvD conv_desc_ada(ArgsP ap, unsigned char* ws, int l_unused, int it) {
    const int l = it / 4608; ConvD d; d.W = ap->in[7] + (size_t)l * DM * NADA; d.WT = (bf16*)(ws + WS_WADA); d.N = NADA; d.ldk = 1024; d.mode = 0; d.roff = l * NADA; d.r = it - l * 4608; return d; }
#define CONV_LOOP(DESC, total) do { LAS float* scr = (LAS float*)(lds + wave * 16384); int it = gw; if (it < (total)) { float va[32], vb[32]; ConvD da = DESC(ap, ws, l, it), db = da; conv_load(va, da, lane); \
        for (;;) { const int i1_ = it + NGW; const bool h1_ = i1_ < (total); if (h1_) { db = DESC(ap, ws, l, i1_); conv_load(vb, db, lane); } conv_store(va, da, scr, lane); if (!h1_) break; \
                   const int i2_ = i1_ + NGW; const bool h2_ = i2_ < (total); if (h2_) { da = DESC(ap, ws, l, i2_); conv_load(va, da, lane); } conv_store(vb, db, scr, lane); if (!h2_) break; it = i2_; } } } while (0)
__device__ __forceinline__ void convert_layer_main(ArgsP ap, unsigned char* ws, int l, LAS unsigned char* lds, int gw, int NGW, int wave, int lane) { CONV_LOOP(conv_desc_main, LAYER_CONV_MAIN); }
__device__ __forceinline__ void convert_layer_w2b(ArgsP ap, unsigned char* ws, int l, LAS unsigned char* lds, int gw, int NGW, int wave, int lane) { CONV_LOOP(conv_desc_w2b, 1408); }
__device__ __forceinline__ void convert_ada_weights(ArgsP ap, unsigned char* ws, LAS unsigned char* lds, int gw, int NGW, int wave, int lane) { const int l = 0; CONV_LOOP(conv_desc_ada, 2 * 4608); }

__device__ __forceinline__ void rms_row_load(f32x4 (&v)[4], const float* xrow, int m, const float* P, int nP, int lane) {
    const f32x4* xr = (const f32x4*)xrow + lane;
#pragma unroll
    for (int j = 0; j < 4; ++j) v[j] = xr[64 * j];
    if (nP > 0 && m >= NPROMPT) {
        for (int q = 0; q < nP; ++q) { const f32x4* pr = (const f32x4*)(P + ((size_t)q * NSAMPLE + (m - NPROMPT)) * DM) + lane;
#pragma unroll
            for (int j = 0; j < 4; ++j) v[j] = v[j] + pr[64 * j]; }
        f32x4* xw = (f32x4*)(const_cast<float*>(xrow)) + lane;
#pragma unroll
        for (int j = 0; j < 4; ++j) xw[64 * j] = v[j]; }
}
__device__ __forceinline__ void rms_row_finish(const f32x4 (&v)[4], int m, float* xcopy, const float* gnorm, const float* ada_l, int sidx, bf16* H, int lane) {
    const float* sh = ada_l + (size_t)seq_of_row(m) * NADA + sidx * 1024; const float* sc = sh + 1024;
    f32x4 g4[4], s4[4], c4[4];
#pragma unroll
    for (int j = 0; j < 4; ++j) { const int c = 4 * (lane + 64 * j); g4[j] = *(const f32x4*)(gnorm + c); s4[j] = *(const f32x4*)(sh + c); c4[j] = *(const f32x4*)(sc + c); }
    float s = 0.f;
#pragma unroll
    for (int j = 0; j < 4; ++j) s += (v[j][0] * v[j][0] + v[j][1] * v[j][1]) + (v[j][2] * v[j][2] + v[j][3] * v[j][3]);
    const float rstd = 1.0f / sqrtf(wave_sum(s) * (1.f / DM) + 1e-6f);
    if (xcopy && m >= NPROMPT) { f32x4* xc = (f32x4*)(xcopy + (size_t)m * DM) + lane;
#pragma unroll
        for (int j = 0; j < 4; ++j) xc[64 * j] = v[j]; }
    u32x2* o8 = (u32x2*)(H + (size_t)m * DM) + lane;
#pragma unroll
    for (int j = 0; j < 4; ++j) { const f32x4 o = v[j] * rstd * g4[j] * (c4[j] + 1.0f) + s4[j];
        u32x2 w; w.x = pk2(o[0], o[1]); w.y = pk2(o[2], o[3]); o8[64 * j] = w; }
}
#define RMS_XROW(mm) ((mm) < NPROMPT ? xp + (size_t)(mm) * DM : xs + (size_t)((mm) - NPROMPT) * DM)
__device__ __forceinline__ void rmsmod_phase(const float* xp, const float* xs, float* xcopy, const float* gnorm, const float* ada_l, int sidx, bf16* H, const float* P, int nP, int gw, int NGW, int lane) {
    int m = gw; if (m >= MTOK) return;
    f32x4 a[4], b[4], c[4];
    rms_row_load(a, RMS_XROW(m), m, P, nP, lane);
    if (m + NGW < MTOK) rms_row_load(b, RMS_XROW(m + NGW), m + NGW, P, nP, lane);
    for (;;) {
        if (m + 2 * NGW < MTOK) rms_row_load(c, RMS_XROW(m + 2 * NGW), m + 2 * NGW, P, nP, lane);
        rms_row_finish(a, m, xcopy, gnorm, ada_l, sidx, H, lane);
        m += NGW; if (m >= MTOK) break;
        if (m + 2 * NGW < MTOK) rms_row_load(a, RMS_XROW(m + 2 * NGW), m + 2 * NGW, P, nP, lane);
        rms_row_finish(b, m, xcopy, gnorm, ada_l, sidx, H, lane);
        m += NGW; if (m >= MTOK) break;
        if (m + 2 * NGW < MTOK) rms_row_load(b, RMS_XROW(m + 2 * NGW), m + 2 * NGW, P, nP, lane);
        rms_row_finish(c, m, xcopy, gnorm, ada_l, sidx, H, lane);
        m += NGW; if (m >= MTOK) break;
    }
}
__device__ __forceinline__ void final_row_finish(const f32x4 (&v)[4], float* x, const float* g, int m, int lane) {
    f32x4 g4[4];
#pragma unroll
    for (int j = 0; j < 4; ++j) g4[j] = *(const f32x4*)(g + 4 * (lane + 64 * j));
    float s = 0.f;
#pragma unroll
    for (int j = 0; j < 4; ++j) s += (v[j][0] * v[j][0] + v[j][1] * v[j][1]) + (v[j][2] * v[j][2] + v[j][3] * v[j][3]);
    const float rstd = 1.0f / sqrtf(wave_sum(s) * (1.f / DM) + 1e-6f);
    f32x4* xr = (f32x4*)(x + (size_t)m * DM) + lane;
#pragma unroll
    for (int j = 0; j < 4; ++j) xr[64 * j] = v[j] * rstd * g4[j];
}
__device__ __forceinline__ void final_norm_phase(float* x, const float* g, const float* P, int nP, int gw, int NGW, int lane) {
    int m = gw; if (m >= MTOK) return;
    f32x4 a[4], b[4];
    rms_row_load(a, x + (size_t)m * DM, m, P, nP, lane);
    for (;;) {
        const int mn = m + NGW; const bool has = mn < MTOK;
        if (has) rms_row_load(b, x + (size_t)mn * DM, mn, P, nP, lane);
        final_row_finish(a, x, g, m, lane);
        if (!has) break;
        const int mn2 = mn + NGW; const bool has2 = mn2 < MTOK;
        if (has2) rms_row_load(a, x + (size_t)mn2 * DM, mn2, P, nP, lane);
        final_row_finish(b, x, g, mn, lane);
        if (!has2) break;
        m = mn2;
    }
}

#define MFMA16(a, b, c) __builtin_amdgcn_mfma_f32_16x16x32_bf16((a), (b), (c), 0, 0, 0)
typedef short s16x4 __attribute__((ext_vector_type(4)));
__device__ __forceinline__ s16x4 trread(const LAS unsigned char* p) { return __builtin_amdgcn_ds_read_tr16_b64_v4i16((LAS s16x4*)p); }
__device__ __forceinline__ s16x4 ld8(const LAS unsigned char* p) { return *(const LAS s16x4*)p; }
__device__ __forceinline__ bf16x8 cat8(s16x4 a, s16x4 b) { return (bf16x8){a[0], a[1], a[2], a[3], b[0], b[1], b[2], b[3]}; }
constexpr int ST64 = 144, ST128 = 288, STY = 272;
constexpr int L2_QS = 0, L2_KS = 18432, L2_VS = 36864, L2_SS = 73728, L2_YS = 92160;

template <bool WITH_Q> __device__ __forceinline__ void ret_load_chunk(LAS unsigned char* lds, const bf16* Q, const bf16* K, const bf16* V, const float* rope, int row0, int pos0, int h, float lg, int tid) {
    const int i = tid >> 2, gq = tid & 3; const size_t rb = (size_t)(row0 + i) * 512 + h * 64 + 8 * gq;
    const u32x4 klo = *(const u32x4*)(K + rb), khi = *(const u32x4*)(K + rb + 32);
    u32x4 qlo = klo, qhi = khi; if (WITH_Q) { qlo = *(const u32x4*)(Q + rb); qhi = *(const u32x4*)(Q + rb + 32); }
    const f32x4* rp = (const f32x4*)(rope + ((size_t)(pos0 + i) * 32 + 8 * gq) * 2);
    const f32x4 r0 = rp[0], r1 = rp[1], r2 = rp[2], r3 = rp[3];
    u32x4 vv[4];
#pragma unroll
    for (int y = 0; y < 4; ++y) vv[y] = *(const u32x4*)(V + (size_t)(row0 + i) * 1024 + h * 128 + 32 * gq + 8 * y);
    const float cs[8] = {r0[0], r0[2], r1[0], r1[2], r2[0], r2[2], r3[0], r3[2]}, sn[8] = {r0[1], r0[3], r1[1], r1[3], r2[1], r2[3], r3[1], r3[3]};
    const unsigned ql[4] = {qlo.x, qlo.y, qlo.z, qlo.w}, qh[4] = {qhi.x, qhi.y, qhi.z, qhi.w}, kl[4] = {klo.x, klo.y, klo.z, klo.w}, kh[4] = {khi.x, khi.y, khi.z, khi.w};
    const float gi = __expf((float)i * lg) * 0.125f, gk = __expf(-(float)i * lg);
    float qa[8], qb[8], ka[8], kb[8];
#pragma unroll
    for (int x = 0; x < 8; ++x) {
        const float k1 = (x & 1) ? bfhi(kl[x >> 1]) : bflo(kl[x >> 1]), k2 = (x & 1) ? bfhi(kh[x >> 1]) : bflo(kh[x >> 1]);
        ka[x] = (k1 * cs[x] - k2 * sn[x]) * gk; kb[x] = (k1 * sn[x] + k2 * cs[x]) * gk;
        if (WITH_Q) { const float q1 = (x & 1) ? bfhi(ql[x >> 1]) : bflo(ql[x >> 1]), q2 = (x & 1) ? bfhi(qh[x >> 1]) : bflo(qh[x >> 1]);
            qa[x] = (q1 * cs[x] - q2 * sn[x]) * gi; qb[x] = (q1 * sn[x] + q2 * cs[x]) * gi; }
    }
    u32x4 t;
    LAS unsigned char* kr = lds + L2_KS + i * ST64 + 16 * gq;
    t.x = pk2(ka[0], ka[1]); t.y = pk2(ka[2], ka[3]); t.z = pk2(ka[4], ka[5]); t.w = pk2(ka[6], ka[7]); *(LAS u32x4*)kr = t;
    t.x = pk2(kb[0], kb[1]); t.y = pk2(kb[2], kb[3]); t.z = pk2(kb[4], kb[5]); t.w = pk2(kb[6], kb[7]); *(LAS u32x4*)(kr + 64) = t;
    if (WITH_Q) { LAS unsigned char* qr = lds + L2_QS + i * ST64 + 16 * gq;
        t.x = pk2(qa[0], qa[1]); t.y = pk2(qa[2], qa[3]); t.z = pk2(qa[4], qa[5]); t.w = pk2(qa[6], qa[7]); *(LAS u32x4*)qr = t;
        t.x = pk2(qb[0], qb[1]); t.y = pk2(qb[2], qb[3]); t.z = pk2(qb[4], qb[5]); t.w = pk2(qb[6], qb[7]); *(LAS u32x4*)(qr + 64) = t; }
#pragma unroll
    for (int y = 0; y < 4; ++y) *(LAS u32x4*)(lds + L2_VS + i * ST128 + 64 * gq + 16 * y) = vv[y];
}

__device__ __forceinline__ void ret_kv_unit(LAS unsigned char* lds, const bf16* K, const bf16* V, const float* rope, float* KVout, int b, int h, int c, int tid) {
    const float lg = lgamma_h(h);
    ret_load_chunk<false>(lds, K, K, V, rope, b * 2048 + c * 128, c * 128, h, lg, tid);
    __syncthreads();
    const int w = __builtin_amdgcn_readfirstlane(tid >> 6), lane = tid & 63, l15 = lane & 15, q4 = lane >> 4, qq = (lane >> 2) & 3, p = lane & 3;
    const int dt = w & 3, et0 = (w >> 2) * 4, rloc = 4 * q4 + qq;
    const LAS unsigned char* kA = lds + L2_KS + rloc * ST64 + (16 * dt + 4 * p) * 2;
    const LAS unsigned char* vB = lds + L2_VS + rloc * ST128 + (4 * p) * 2;
    f32x4 kv[4];
#pragma unroll
    for (int x = 0; x < 4; ++x) kv[x] = (f32x4){0.f, 0.f, 0.f, 0.f};
#pragma unroll
    for (int ks = 0; ks < 4; ++ks) { const bf16x8 a = cat8(trread(kA + (32 * ks) * ST64), trread(kA + (32 * ks + 16) * ST64));
#pragma unroll
        for (int x = 0; x < 4; ++x) { const bf16x8 bb = cat8(trread(vB + (32 * ks) * ST128 + 32 * (et0 + x)), trread(vB + (32 * ks + 16) * ST128 + 32 * (et0 + x))); kv[x] = MFMA16(a, bb, kv[x]); } }
#pragma unroll
    for (int x = 0; x < 4; ++x)
#pragma unroll
        for (int r = 0; r < 4; ++r) KVout[(16 * dt + 4 * q4 + r) * 128 + 16 * (et0 + x) + l15] = kv[x][r];
    __syncthreads();
}

__device__ __forceinline__ void ret_scan(const float* KVB, bf16* SCB, float* Sfin  , int gtid, int gthreads) {
    for (int idx = gtid; idx < 64 * 2048; idx += gthreads) { const int bh = idx >> 11, e4 = (idx & 2047) * 4; const float lg = lgamma_h(bh & 7);
        const float gam = __expf(lg), cd = __expf(128.f * lg), g127 = __expf(127.f * lg);
        const float* kvp = KVB + (size_t)bh * 16 * 8192 + e4; bf16* scp = SCB + (size_t)bh * 16 * 8192 + e4;
        f32x4 kvv[16];
#pragma unroll
        for (int c = 0; c < 16; ++c) kvv[c] = *(const f32x4*)(kvp + c * 8192);
        f32x4 acc = (f32x4){0.f, 0.f, 0.f, 0.f};
#pragma unroll
        for (int c = 0; c < 16; ++c) { u32x2 t; t.x = pk2(gam * acc[0], gam * acc[1]); t.y = pk2(gam * acc[2], gam * acc[3]); *(u32x2*)(scp + c * 8192) = t; acc = acc * cd + kvv[c] * g127; }
        *(f32x4*)(Sfin + (size_t)bh * 8192 + e4) = acc; }
}

struct R2Regs { u32x4 klo, khi, qlo, qhi, vv[4], sc[2]; };
__device__ __forceinline__ void ret_out_fetch(R2Regs& R, const bf16* Q, const bf16* K, const bf16* V, const bf16* G, const float* rope, const bf16* SC, int b, int h, int c, int tid) {
    const int row0 = b * 2048 + c * 128, i = tid >> 2, gq = tid & 3; const size_t rb = (size_t)(row0 + i) * 512 + h * 64 + 8 * gq;
    R.klo = *(const u32x4*)(K + rb); R.khi = *(const u32x4*)(K + rb + 32); R.qlo = *(const u32x4*)(Q + rb); R.qhi = *(const u32x4*)(Q + rb + 32);
#pragma unroll
    for (int y = 0; y < 4; ++y) R.vv[y] = *(const u32x4*)(V + (size_t)(row0 + i) * 1024 + h * 128 + 32 * gq + 8 * y);
#pragma unroll
    for (int y = 0; y < 2; ++y) { const int idx = tid + 512 * y; R.sc[y] = *(const u32x4*)(SC + (idx >> 4) * 128 + (idx & 15) * 8); }
}
__device__ __forceinline__ void ret_out_stage(LAS unsigned char* lds, const R2Regs& R, const bf16* G, const float* rope, u32x4 (&gpre)[4], int b, int h, int c, int tid) {
    const float lg = lgamma_h(h); const int i = tid >> 2, gq = tid & 3;
    const f32x4* rp = (const f32x4*)(rope + ((size_t)(c * 128 + i) * 32 + 8 * gq) * 2);
    const f32x4 r0 = rp[0], r1 = rp[1], r2 = rp[2], r3 = rp[3];
    {   const int row0 = b * 2048 + c * 128, w_ = tid >> 6, lane_ = tid & 63;
#pragma unroll
        for (int y = 0; y < 4; ++y) { const int idx = lane_ + 64 * y; gpre[y] = *(const u32x4*)(G + (size_t)(row0 + 16 * w_ + (idx >> 4)) * 1024 + h * 128 + (idx & 15) * 8); } }
    const float cs[8] = {r0[0], r0[2], r1[0], r1[2], r2[0], r2[2], r3[0], r3[2]}, sn[8] = {r0[1], r0[3], r1[1], r1[3], r2[1], r2[3], r3[1], r3[3]};
    const unsigned ql[4] = {R.qlo.x, R.qlo.y, R.qlo.z, R.qlo.w}, qh[4] = {R.qhi.x, R.qhi.y, R.qhi.z, R.qhi.w}, kl[4] = {R.klo.x, R.klo.y, R.klo.z, R.klo.w}, kh[4] = {R.khi.x, R.khi.y, R.khi.z, R.khi.w};
    const float gi = __expf((float)i * lg) * 0.125f, gk = __expf(-(float)i * lg);
    float qa[8], qb[8], ka[8], kb[8];
#pragma unroll
    for (int x = 0; x < 8; ++x) {
        const float k1 = (x & 1) ? bfhi(kl[x >> 1]) : bflo(kl[x >> 1]), k2 = (x & 1) ? bfhi(kh[x >> 1]) : bflo(kh[x >> 1]);
        ka[x] = (k1 * cs[x] - k2 * sn[x]) * gk; kb[x] = (k1 * sn[x] + k2 * cs[x]) * gk;
        const float q1 = (x & 1) ? bfhi(ql[x >> 1]) : bflo(ql[x >> 1]), q2 = (x & 1) ? bfhi(qh[x >> 1]) : bflo(qh[x >> 1]);
        qa[x] = (q1 * cs[x] - q2 * sn[x]) * gi; qb[x] = (q1 * sn[x] + q2 * cs[x]) * gi;
    }
    u32x4 t;
    LAS unsigned char* kr = lds + L2_KS + i * ST64 + 16 * gq;
    t.x = pk2(ka[0], ka[1]); t.y = pk2(ka[2], ka[3]); t.z = pk2(ka[4], ka[5]); t.w = pk2(ka[6], ka[7]); *(LAS u32x4*)kr = t;
    t.x = pk2(kb[0], kb[1]); t.y = pk2(kb[2], kb[3]); t.z = pk2(kb[4], kb[5]); t.w = pk2(kb[6], kb[7]); *(LAS u32x4*)(kr + 64) = t;
    LAS unsigned char* qr = lds + L2_QS + i * ST64 + 16 * gq;
    t.x = pk2(qa[0], qa[1]); t.y = pk2(qa[2], qa[3]); t.z = pk2(qa[4], qa[5]); t.w = pk2(qa[6], qa[7]); *(LAS u32x4*)qr = t;
    t.x = pk2(qb[0], qb[1]); t.y = pk2(qb[2], qb[3]); t.z = pk2(qb[4], qb[5]); t.w = pk2(qb[6], qb[7]); *(LAS u32x4*)(qr + 64) = t;
#pragma unroll
    for (int y = 0; y < 4; ++y) *(LAS u32x4*)(lds + L2_VS + i * ST128 + 64 * gq + 16 * y) = R.vv[y];
#pragma unroll
    for (int y = 0; y < 2; ++y) { const int idx = tid + 512 * y, d = idx >> 4, ch = idx & 15; *(LAS u32x4*)(lds + L2_SS + d * ST128 + ch * 16) = R.sc[y]; }
}
__device__ __forceinline__ void ret_out_compute(LAS unsigned char* lds, bf16* G, const float* gn_g, const u32x4 (&gpre)[4], int b, int h, int c, int tid) {
    const int row0 = b * 2048 + c * 128;
    const int w = __builtin_amdgcn_readfirstlane(tid >> 6), lane = tid & 63, l15 = lane & 15, q4 = lane >> 4, qq = (lane >> 2) & 3, p = lane & 3;
    const int rloc = 4 * q4 + qq;
    const LAS unsigned char* qrow = lds + L2_QS + (16 * w + l15) * ST64 + 8 * q4;
    const bf16x8 Qf0 = cat8(ld8(qrow), ld8(qrow + 32)), Qf1 = cat8(ld8(qrow + 64), ld8(qrow + 96));
    const LAS unsigned char* vB = lds + L2_VS + rloc * ST128 + 8 * p;
    const LAS unsigned char* sB = lds + L2_SS + rloc * ST128 + 8 * p;
    f32x4 o[8];
#pragma unroll
    for (int et = 0; et < 8; ++et) o[et] = (f32x4){0.f, 0.f, 0.f, 0.f};
    const int irow = 16 * w + l15;
    for (int ks = 0; ks <= (w >> 1); ++ks) {
        const LAS unsigned char* k0 = lds + L2_KS + (32 * ks + l15) * ST64 + 8 * q4; const LAS unsigned char* k1 = k0 + 16 * ST64;
        f32x4 s0 = (f32x4){0.f, 0.f, 0.f, 0.f}, s1 = s0;
        s0 = MFMA16(cat8(ld8(k0), ld8(k0 + 32)), Qf0, s0); s0 = MFMA16(cat8(ld8(k0 + 64), ld8(k0 + 96)), Qf1, s0);
        s1 = MFMA16(cat8(ld8(k1), ld8(k1 + 32)), Qf0, s1); s1 = MFMA16(cat8(ld8(k1 + 64), ld8(k1 + 96)), Qf1, s1);
        const int j0 = 32 * ks + 4 * q4;
#pragma unroll
        for (int r = 0; r < 4; ++r) { s0[r] = (j0 + r <= irow) ? s0[r] : 0.f; s1[r] = (j0 + 16 + r <= irow) ? s1[r] : 0.f; }
        u32x4 pw; pw.x = pk2(s0[0], s0[1]); pw.y = pk2(s0[2], s0[3]); pw.z = pk2(s1[0], s1[1]); pw.w = pk2(s1[2], s1[3]);
        const bf16x8 pa = __builtin_bit_cast(bf16x8, pw);
#pragma unroll
        for (int et = 0; et < 8; ++et) { const bf16x8 bb = cat8(trread(vB + (32 * ks) * ST128 + 32 * et), trread(vB + (32 * ks + 16) * ST128 + 32 * et)); o[et] = MFMA16(pa, bb, o[et]); }
    }
#pragma unroll
    for (int ks = 0; ks < 2; ++ks) { const bf16x8 a = ks ? Qf1 : Qf0;
#pragma unroll
        for (int et = 0; et < 8; ++et) { const bf16x8 bb = cat8(trread(sB + (32 * ks) * ST128 + 32 * et), trread(sB + (32 * ks + 16) * ST128 + 32 * et)); o[et] = MFMA16(a, bb, o[et]); } }
    float gg[8];
#pragma unroll
    for (int et = 0; et < 8; ++et) gg[et] = gn_g[h * 128 + 16 * et + l15];
#pragma unroll
    for (int r = 0; r < 4; ++r) {
        float s = 0.f;
#pragma unroll
        for (int et = 0; et < 8; ++et) s += o[et][r];
        s += __shfl_xor(s, 1); s += __shfl_xor(s, 2); s += __shfl_xor(s, 4); s += __shfl_xor(s, 8);
        const float mean = s * (1.f / 128.f); float vs = 0.f;
#pragma unroll
        for (int et = 0; et < 8; ++et) { const float d = o[et][r] - mean; vs += d * d; }
        vs += __shfl_xor(vs, 1); vs += __shfl_xor(vs, 2); vs += __shfl_xor(vs, 4); vs += __shfl_xor(vs, 8);
        const float rstd = 1.0f / sqrtf(vs * (1.f / 128.f) + 1e-5f);
        LAS bf16* yr = (LAS bf16*)(lds + L2_YS + (16 * w + 4 * q4 + r) * STY) + l15;
#pragma unroll
        for (int et = 0; et < 8; ++et) yr[16 * et] = (bf16)f2bf((o[et][r] - mean) * rstd * gg[et]);
    }
#pragma unroll
    for (int y = 0; y < 4; ++y) { const int idx = lane + 64 * y, rr = 16 * w + (idx >> 4), ch = idx & 15;
        const u32x4 yv = *(const LAS u32x4*)(lds + L2_YS + rr * STY + ch * 16);
        bf16* gp = G + (size_t)(row0 + rr) * 1024 + h * 128 + ch * 8; const u32x4 gv = gpre[y];
        u32x4 ov;
        ov.x = pk2(siluf_(bflo(gv.x)) * bflo(yv.x), siluf_(bfhi(gv.x)) * bfhi(yv.x)); ov.y = pk2(siluf_(bflo(gv.y)) * bflo(yv.y), siluf_(bfhi(gv.y)) * bfhi(yv.y));
        ov.z = pk2(siluf_(bflo(gv.z)) * bflo(yv.z), siluf_(bfhi(gv.z)) * bfhi(yv.z)); ov.w = pk2(siluf_(bflo(gv.w)) * bflo(yv.w), siluf_(bfhi(gv.w)) * bfhi(yv.w));
        *(u32x4*)gp = ov; }
    __syncthreads();
}


__device__ __forceinline__ void ret_sample_unit(LAS unsigned char* lds, const bf16* Q, const bf16* K, const bf16* V, bf16* G, const float* rope, const float* gn_g, const float* S0, float* Sout, int bs, int h, int tid) {
    LAS float* qf = (LAS float*)lds; LAS float* kf = qf + 512; LAS float* vf = kf + 512; LAS float* sc = vf + 1024; LAS float* oc = sc + 64; LAS float* ob = oc + 4096;
    const int w = tid >> 6, lane = tid & 63; const float lg = lgamma_h(h); const int row0 = NPROMPT + bs * 8;
    {   const int which = tid >> 8, t2 = tid & 255, i = t2 >> 5, d = t2 & 31; const bf16* src = which ? K : Q; const size_t rb = (size_t)(row0 + i) * 512 + h * 64 + d;
        const float x1 = bf2f(src[rb]), x2 = bf2f(src[rb + 32]); const float cs = rope[((size_t)(2048 + i) * 32 + d) * 2], sn = rope[((size_t)(2048 + i) * 32 + d) * 2 + 1];
        const float scale = which ? 1.0f : 0.125f; LAS float* dst = which ? kf : qf;
        dst[i * 64 + d] = (x1 * cs - x2 * sn) * scale; dst[i * 64 + 32 + d] = (x1 * sn + x2 * cs) * scale; }
#pragma unroll
    for (int y = 0; y < 2; ++y) { const int idx = tid + 512 * y, j = idx >> 7, e = idx & 127; vf[idx] = bf2f(V[(size_t)(row0 + j) * 1024 + h * 128 + e]); }
    __syncthreads();
    if (tid < 64) { const int i = tid >> 3, j = tid & 7; float s = 0.f;
        if (j <= i) { for (int d = 0; d < 64; ++d) s += qf[i * 64 + d] * kf[j * 64 + d]; s *= __expf((float)(i - j) * lg); }
        sc[tid] = s; }
    const int e = tid & 127, dg = tid >> 7;
    float Sreg[16];
#pragma unroll
    for (int dd = 0; dd < 16; ++dd) Sreg[dd] = S0[(dg * 16 + dd) * 128 + e];
#pragma unroll
    for (int i = 0; i < 8; ++i) { float p = 0.f;
#pragma unroll
        for (int dd = 0; dd < 16; ++dd) p += qf[i * 64 + dg * 16 + dd] * Sreg[dd];
        oc[(dg * 8 + i) * 128 + e] = p; }
    const float g8 = __expf(8.f * lg);
    float vdec[8];
#pragma unroll
    for (int j = 0; j < 8; ++j) vdec[j] = __expf((float)(7 - j) * lg) * vf[j * 128 + e];
#pragma unroll
    for (int dd = 0; dd < 16; ++dd) { float acc = Sreg[dd] * g8;
#pragma unroll
        for (int j = 0; j < 8; ++j) acc += kf[j * 64 + dg * 16 + dd] * vdec[j];
        Sout[(dg * 16 + dd) * 128 + e] = acc; }
    __syncthreads();
#pragma unroll
    for (int y = 0; y < 2; ++y) { const int idx = tid + 512 * y, i = idx >> 7, ee = idx & 127;
        float o = (oc[(0 + i) * 128 + ee] + oc[(8 + i) * 128 + ee] + oc[(16 + i) * 128 + ee] + oc[(24 + i) * 128 + ee]) * __expf((float)(i + 1) * lg);
        for (int j = 0; j <= i; ++j) o += sc[i * 8 + j] * vf[j * 128 + ee];
        ob[idx] = o; }
    __syncthreads();
    {   const int i = w; const float v0 = ob[i * 128 + lane], v1 = ob[i * 128 + 64 + lane];
        const float mean = wave_sum(v0 + v1) * (1.f / 128.f); const float d0 = v0 - mean, d1 = v1 - mean;
        const float rstd = 1.0f / sqrtf(wave_sum(d0 * d0 + d1 * d1) * (1.f / 128.f) + 1e-5f);
        bf16* gp = G + (size_t)(row0 + i) * 1024 + h * 128 + lane;
        const float g0 = bf2f(gp[0]), g1 = bf2f(gp[64]);
        gp[0] = (bf16)f2bf(siluf_(g0) * d0 * rstd * gn_g[h * 128 + lane]); gp[64] = (bf16)f2bf(siluf_(g1) * d1 * rstd * gn_g[h * 128 + 64 + lane]); }
    __syncthreads();
}

template <int NT> __device__ __forceinline__ void conf_unit(LAS unsigned char* lds, const bf16* CA, const bf16* CB, bf16* XCS, const float* cw, const float* cbias, const float* lng, const float* lnb,
                                                             const float* state, float* state_out, int seqrow0, int t0, int T, int tid) {
    LAS float* U = (LAS float*)lds; LAS float* CV = U + 46 * 512;
    const int c = tid, w = tid >> 6, lane = tid & 63;
    float wreg[31];
#pragma unroll
    for (int k = 0; k < 31; ++k) wreg[k] = cw[k * 512 + c];
    const float bias = cbias[c];
#pragma unroll
    for (int itn = 0; itn < ((30 + NT) * 64 + NTHREADS - 1) / NTHREADS; ++itn) { const int it = tid + itn * NTHREADS; if (it < (30 + NT) * 64) {
        const int r = it >> 6, c0 = (it & 63) * 8; f32x4 u0 = (f32x4){0.f, 0.f, 0.f, 0.f}, u1 = u0;
        if (state && r < 30) { u0 = *(const f32x4*)(state + r * 512 + c0); u1 = *(const f32x4*)(state + r * 512 + c0 + 4); }
        else { const int t = t0 - 30 + r;
            if (t >= 0) { const size_t gi = (size_t)(seqrow0 + t) * 512 + c0; const u32x4 av = *(const u32x4*)(CA + gi);
                u0[0] = bflo(av.x); u0[1] = bfhi(av.x); u0[2] = bflo(av.y); u0[3] = bfhi(av.y); u1[0] = bflo(av.z); u1[1] = bfhi(av.z); u1[2] = bflo(av.w); u1[3] = bfhi(av.w);
                if (!state && r >= 30 && t >= T - 30) { float* so = state_out + (size_t)(t - (T - 30)) * 512 + c0; *(f32x4*)so = u0; *(f32x4*)(so + 4) = u1; } } }
        *(LAS f32x4*)(U + r * 512 + c0) = u0; *(LAS f32x4*)(U + r * 512 + c0 + 4) = u1;
    } }
    __syncthreads();
    if (state) { for (int it = tid; it < 30 * 128; it += NTHREADS) { const int rr = it >> 7, c4 = (it & 127) * 4; *(f32x4*)(state_out + rr * 512 + c4) = *(const LAS f32x4*)(U + (rr + NT) * 512 + c4); } }
    float cv[NT];
#pragma unroll
    for (int tt = 0; tt < NT; ++tt) cv[tt] = bias;
#pragma unroll
    for (int r = 0; r < 30 + NT; ++r) { const float u = U[r * 512 + c];
#pragma unroll
        for (int tt = 0; tt < NT; ++tt) { if (r - tt >= 0 && r - tt <= 30) cv[tt] += wreg[r - tt] * u; } }
#pragma unroll
    for (int tt = 0; tt < NT; ++tt) CV[tt * 512 + c] = cv[tt];
    __syncthreads();
    for (int tt = w; tt < NT; tt += 8) {
        const f32x4 x0 = *(const LAS f32x4*)(CV + tt * 512 + lane * 8), x1 = *(const LAS f32x4*)(CV + tt * 512 + lane * 8 + 4);
        const float mean = wave_sum((x0[0] + x0[1]) + (x0[2] + x0[3]) + (x1[0] + x1[1]) + (x1[2] + x1[3])) * (1.f / 512.f);
        const f32x4 d0 = x0 - mean, d1 = x1 - mean;
        const float var = wave_sum((d0[0] * d0[0] + d0[1] * d0[1]) + (d0[2] * d0[2] + d0[3] * d0[3]) + (d1[0] * d1[0] + d1[1] * d1[1]) + (d1[2] * d1[2] + d1[3] * d1[3])) * (1.f / 512.f);
        const float rstd = 1.0f / sqrtf(var + 1e-5f);
        const f32x4 g0 = *(const f32x4*)(lng + lane * 8), g1 = *(const f32x4*)(lng + lane * 8 + 4), b0 = *(const f32x4*)(lnb + lane * 8), b1 = *(const f32x4*)(lnb + lane * 8 + 4);
        const f32x4 y0 = d0 * rstd * g0 + b0, y1 = d1 * rstd * g1 + b1;
        u32x4 o; o.x = pk2(siluf_(y0[0]), siluf_(y0[1])); o.y = pk2(siluf_(y0[2]), siluf_(y0[3])); o.z = pk2(siluf_(y1[0]), siluf_(y1[1])); o.w = pk2(siluf_(y1[2]), siluf_(y1[3]));
        *(u32x4*)(XCS + (size_t)(seqrow0 + t0 + tt) * 1024 + lane * 8) = o;
    }
    __syncthreads();
}

__device__ __forceinline__ void sconv_unit(const bf16* SB, const bf16* SCC, const bf16* SX, bf16* XCS, const float* scw, const float* state_l  , float* outp_l  , float* outs_l  , int tile, int tid) {
#pragma unroll
    for (int y = 0; y < 2; ++y) {
        const int item = tid + 512 * y, R = tile * 16 + (item >> 6), c0 = (item & 63) * 8;
        const bool prompt = R < NPROMPT; const int t = prompt ? (R & 2047) : ((R - NPROMPT) & 7); const int sq = prompt ? (R >> 11) : ((R - NPROMPT) >> 3);
        float us[3][8];
#pragma unroll
        for (int k = 0; k < 3; ++k) { const int tp = t - 2 + k;
            if (tp >= 0) { const size_t gi = (size_t)(R - 2 + k) * 512 + c0; const u32x4 a = *(const u32x4*)(SCC + gi);
                const unsigned aw[4] = {a.x, a.y, a.z, a.w};
#pragma unroll
                for (int x = 0; x < 4; ++x) { us[k][2 * x] = bflo(aw[x]); us[k][2 * x + 1] = bfhi(aw[x]); } }
            else if (prompt) {
#pragma unroll
                for (int x = 0; x < 8; ++x) us[k][x] = 0.f; }
            else { const float* sp = state_l + ((size_t)sq * 2 + (2 + tp)) * 512 + c0; const f32x4 s0 = *(const f32x4*)sp, s1 = *(const f32x4*)(sp + 4);
#pragma unroll
                for (int x = 0; x < 4; ++x) { us[k][x] = s0[x]; us[k][4 + x] = s1[x]; } } }
        const u32x4 sbv = *(const u32x4*)(SB + (size_t)R * 512 + c0); const unsigned sw[4] = {sbv.x, sbv.y, sbv.z, sbv.w};
        float o[8];
#pragma unroll
        for (int x = 0; x < 8; ++x) { const float sv = scw[c0 + x] * us[0][x] + scw[512 + c0 + x] * us[1][x] + scw[1024 + c0 + x] * us[2][x];
            o[x] = ((x & 1) ? bfhi(sw[x >> 1]) : bflo(sw[x >> 1])) * sv; }
        u32x4 ow; ow.x = pk2(o[0], o[1]); ow.y = pk2(o[2], o[3]); ow.z = pk2(o[4], o[5]); ow.w = pk2(o[6], o[7]);
        *(u32x4*)(XCS + (size_t)R * 1024 + 512 + c0) = ow;
        const int tl = prompt ? 2046 : 6;
        if (t >= tl) { float* op = (prompt ? outp_l : outs_l) + ((size_t)sq * 2 + (t - tl)) * 512 + c0;
            *(f32x4*)op = (f32x4){us[2][0], us[2][1], us[2][2], us[2][3]}; *(f32x4*)(op + 4) = (f32x4){us[2][4], us[2][5], us[2][6], us[2][7]}; }
    }
}


#define XB_TMO      128
#define XB_XCNT(j)  (256  + 64 * (j))
#define XB_XSUB(j)  (1280 + 64 * (j))
#define XB_XGEN(j)  (2304 + 64 * (j))
#define XB_TOP      3328
#define XB_TOPGEN   3392
#define XCD_BAR_WORDS 3456
#define XB_SPIN_CAP (1u << 18)

__device__ __forceinline__ unsigned xb_ld(unsigned* p)              { return __hip_atomic_load(p, __ATOMIC_RELAXED, __HIP_MEMORY_SCOPE_AGENT); }
__device__ __forceinline__ unsigned xb_add(unsigned* p, unsigned v) { return __hip_atomic_fetch_add(p, v, __ATOMIC_RELAXED, __HIP_MEMORY_SCOPE_AGENT); }
__device__ __forceinline__ unsigned xb_xcc_id() { return (unsigned)__builtin_amdgcn_s_getreg((3 << 11) | 20) & 0xFu; }
#define XB_SPIN(cond, bar) do { unsigned _sp = 0; while (cond) { __builtin_amdgcn_s_sleep(1); \
    if ((++_sp & 255u) == 0u) { if (xb_ld(&(bar)[XB_TMO])) break; if (_sp > XB_SPIN_CAP) { atomicAdd(&(bar)[XB_TMO], 1u); break; } } } } while (0)

struct XcdBarrier {
    unsigned* bar; unsigned x;
    volatile LAS unsigned* st;
};

__device__ __forceinline__ XcdBarrier xcd_barrier_post(unsigned* bar, volatile LAS unsigned* st) {
    XcdBarrier b; b.bar = bar; b.x = xb_xcc_id(); b.st = st;
    if (threadIdx.x == 0) (void)xb_add(&bar[XB_XCNT(b.x)], 1u);
    return b;
}
__device__ __forceinline__ void xcd_barrier_complete(unsigned* bar, unsigned x, unsigned& nloc, unsigned& nx) {
    const unsigned G = gridDim.x * gridDim.y * gridDim.z;
    unsigned sum, cnt, mine, sp = 0u;
    for (;;) {
        sum = 0u; cnt = 0u; mine = 0u;
#pragma unroll
        for (unsigned j = 0; j < 16; ++j) { const unsigned c = xb_ld(&bar[XB_XCNT(j)]); sum += c; cnt += (c > 0u) ? 1u : 0u; mine = (j == x) ? c : mine; }
        if (sum == G) break;
        __builtin_amdgcn_s_sleep(1);
        if ((++sp & 255u) == 0u) { if (xb_ld(&bar[XB_TMO])) break; if (sp > XB_SPIN_CAP) { atomicAdd(&bar[XB_TMO], 1u); break; } }
    }
    nloc = mine > 0u ? mine : 1u; nx = cnt > 0u ? cnt : 1u;
}

__device__ __forceinline__ void xcd_barrier(const XcdBarrier& b) {
    asm volatile("s_waitcnt vmcnt(0)" ::: "memory");
    __syncthreads();
    if (threadIdx.x == 0) {
        unsigned* bar = b.bar;
        __builtin_amdgcn_s_waitcnt(0);
        unsigned nloc = b.st[0], nx = b.st[1];
        if (nloc == 0u) { xcd_barrier_complete(bar, b.x, nloc, nx); b.st[0] = nloc; b.st[1] = nx; }
        const unsigned old = xb_add(&bar[XB_XSUB(b.x)], 1u);
        const unsigned gen = old / nloc;
        if (old + 1u == (gen + 1u) * nloc) {
            __builtin_amdgcn_fence(__ATOMIC_RELEASE, "agent");
            asm volatile("s_waitcnt vmcnt(0)" ::: "memory");
            const unsigned og = xb_add(&bar[XB_TOP], 1u);
            const unsigned tg = og / nx;
            if (og + 1u == (tg + 1u) * nx) xb_add(&bar[XB_TOPGEN], 1u);
            else XB_SPIN(xb_ld(&bar[XB_TOPGEN]) == tg, bar);
            __builtin_amdgcn_fence(__ATOMIC_ACQUIRE, "agent");
            xb_add(&bar[XB_XGEN(b.x)], 1u);
            asm volatile("s_waitcnt vmcnt(0)" ::: "memory");
        } else {
            XB_SPIN(xb_ld(&bar[XB_XGEN(b.x)]) == gen, bar);
            __builtin_amdgcn_fence(__ATOMIC_ACQUIRE, "agent");
            asm volatile("s_waitcnt vmcnt(0)" ::: "memory");
        }
    }
    __syncthreads();
}


__global__ void __launch_bounds__(NTHREADS, 2) mega_fwd(Args a) {
    extern __shared__ __attribute__((aligned(16))) unsigned char lds_raw[];
    cg::grid_group grid = cg::this_grid();
    LAS unsigned char* lds = (LAS unsigned char*)lds_raw;
    const int G = gridDim.x, bid0 = blockIdx.x, NGW = G * NWAVES;
    volatile LAS unsigned* bst = (volatile LAS unsigned*)(lds + 131072 + 64);
    if (threadIdx.x < 2) bst[threadIdx.x] = 0u;
    __syncthreads();
    const unsigned xcc_x = (unsigned)__builtin_amdgcn_readfirstlane((int)xcd_barrier_post((unsigned*)(a.ws + WS_BAR), bst).x);
#define GRID_BAR() do { ArgsP apb_ = (ArgsP)__builtin_amdgcn_kernarg_segment_ptr(); asm volatile("" : "+s"(apb_)); unsigned x_ = xcc_x; asm volatile("" : "+s"(x_)); XcdBarrier b_; b_.bar = (unsigned*)(apb_->ws + WS_BAR); b_.x = x_; b_.st = bst; PR_T0(10); xcd_barrier(b_); PR_T1(10); } while (0)
#ifdef PROBE_CAT
    unsigned long long pr_acc = 0ull, pr_t0 = 0ull;
#define PR_T0(cat) do { if ((cat) == PROBE_CAT) pr_t0 = __builtin_amdgcn_s_memrealtime(); } while (0)
#define PR_T1(cat) do { if ((cat) == PROBE_CAT) pr_acc += __builtin_amdgcn_s_memrealtime() - pr_t0; } while (0)
#else
#define PR_T0(cat) do {} while (0)
#define PR_T1(cat) do {} while (0)
#endif
#define PHASE_BEGIN ArgsP ap = (ArgsP)__builtin_amdgcn_kernarg_segment_ptr(); asm volatile("" : "+s"(ap)); unsigned char* ws = ap->ws; float* XW = ap->out; int tid = threadIdx.x; asm volatile("" : "+v"(tid)); int bid = bid0; asm volatile("" : "+s"(bid)); \
    const int lane = tid & 63, wave = __builtin_amdgcn_readfirstlane(tid >> 6), gw = bid * NWAVES + wave; \
    float* ADA = (float*)(ws + WS_ADA); float* ROPE = (float*)(ws + WS_ROPE); bf16* H = (bf16*)(ws + WS_H); bf16* U = (bf16*)(ws + WS_U); \
    (void)lane; (void)wave; (void)gw; (void)ADA; (void)ROPE; (void)H; (void)U; (void)XW;
#define GEMM_PHASE(EPI, Aptr, Bptr, Mm, Nn, Kk, lda_, ldb_, ...) { pg8::Gemm g{(const bf16*)(Aptr), (const bf16*)(Bptr), (Mm), (Nn), (Kk), (lda_), (ldb_), 1 << 30, 0l}; pg8::StaticOrder S; S.init((Mm), (Nn), G, bid, (Kk)); \
        EPI E{__VA_ARGS__}; pg8::gemm_phase<EPI, pg8::StaticOrder, true, true>(lds, g, S, E); }
#define GEMM_PHASE_SPLIT(EPI, Aptr, Bptr, Nn, Kk, lda_, ldb_, SPL, ...) { pg8::Gemm g{(const bf16*)(Aptr), (const bf16*)(Bptr), MTOK, (Nn), (Kk), (lda_), (ldb_), 1 << 30, 0l}; pg8::SplitOrder S; S.init(MTOK, (Nn), G, bid, (Kk), (SPL)); \
        EPI E{__VA_ARGS__}; pg8::gemm_phase<EPI, pg8::SplitOrder, true, true>(lds, g, S, E); }

    {   PHASE_BEGIN
        PR_T0(1);
#if PHASES & 1
        convert_ada_weights(ap, ws, lds, gw, NGW, wave, lane);
#endif
        bf16* CS = (bf16*)(ws + WS_CSIL);
        for (int i = bid * NTHREADS + tid; i < 256 * 1024; i += G * NTHREADS) { const int r = i >> 10, c = i & 1023; float v = 0.f;
            if (r < 8) v = siluf_(ap->in[2][r * 1024 + c]); else if (r < NSEQ) v = siluf_(ap->in[3][(r - 8) * 1024 + c]);
            CS[i] = (bf16)f2bf(v); }
        for (int i = bid * NTHREADS + tid; i < 2056 * 32; i += G * NTHREADS) { const int p = i >> 5, k = i & 31; const int pos = p < 2048 ? p : 16384 + (p - 2048);
            double f = 0.15915494309189535; for (int q = 0; q < k; ++q) f *= 0.7498942093324559;
            double rv = (double)pos * f; rv -= __builtin_floor(rv); const float fr = (float)rv;
            ROPE[2 * i] = __builtin_amdgcn_cosf(fr); ROPE[2 * i + 1] = __builtin_amdgcn_sinf(fr); }
        PR_T1(1);
    }
    grid.sync();
    {   PHASE_BEGIN
        GEMM_PHASE(EpiAda, ws + WS_CSIL, ws + WS_WADA, 256, 2 * NADA, 1024, 1024, 1024, ADA, ap->in[8])
        __syncthreads();
        if (G >= 136) { if (bid >= 72) { convert_layer_main(ap, ws, 0, lds, (bid - 72) * NWAVES + wave, (G - 72) * NWAVES, wave, lane); convert_layer_w2b(ap, ws, 0, lds, (bid - 72) * NWAVES + wave, (G - 72) * NWAVES, wave, lane); } }
        else { convert_layer_main(ap, ws, 0, lds, gw, NGW, wave, lane); convert_layer_w2b(ap, ws, 0, lds, gw, NGW, wave, lane); }
    }
    GRID_BAR();

#pragma unroll 1
    for (int l = 0; l < 2; ++l) {
        {   PHASE_BEGIN
            const float* ada_l = ADA + (size_t)l * NSEQ * NADA;
            PR_T0(2);
            if (l == 0) rmsmod_phase(ap->in[0], ap->in[1], XW, ap->in[9], ada_l, 0, H, nullptr, 0, gw, NGW, lane);
            else { rmsmod_phase(XW, XW + (size_t)NPROMPT * DM, nullptr, ap->in[9] + l * DM, ada_l, 0, H, (const float*)(ws + WS_KVB), 4, gw, NGW, lane);
                convert_layer_w2b(ap, ws, l, lds, gw, NGW, wave, lane);
            } PR_T1(2); }
        GRID_BAR();
        {   PHASE_BEGIN
#if PHASES & 2
            GEMM_PHASE(EpiSwiglu, H, ws + WS_W13A, MTOK, 2 * DFF, 1024, 1024, 1024, U)
#ifdef PROBE_UP
            GEMM_PHASE(EpiSwiglu, H, ws + WS_W13A, MTOK, 2 * DFF, 1024, 1024, 1024, U)
#endif
#endif
        }
        GRID_BAR();
        {   PHASE_BEGIN
            const float* ada_l = ADA + (size_t)l * NSEQ * NADA;
#if PHASES & 4
            GEMM_PHASE_SPLIT(EpiResid, U, ws + WS_W2A, DM, DFF, DFF, DFF, 4, XW, (float*)ws, l * NSEQ * NADA + 2 * 1024, 0.5f, DFF / 64, l == 0 ? (long)(ap->in[0] - XW) : 0l)
#endif
        }
        GRID_BAR();
        {   PHASE_BEGIN
            const float* ada_l = ADA + (size_t)l * NSEQ * NADA;
            PR_T0(2); rmsmod_phase(XW, XW + (size_t)NPROMPT * DM, nullptr, ap->in[13] + l * DM, ada_l, 3, H, (const float*)(ws + WS_KVB), 4, gw, NGW, lane); PR_T1(2); }
        GRID_BAR();
        {   PHASE_BEGIN
#if PHASES & 16
            if (G >= 64) { pg8::Gemm g{(const bf16*)H, (const bf16*)(ws + WS_WIN), MTOK, INCOLS, 1024, 1024, 1024, 1 << 30, 0l}; pg8::WinOrder S; S.init(MTOK, G, bid, 1024);
                EpiWin E{ws}; pg8::gemm_phase<EpiWin, pg8::WinOrder, true, true>(lds, g, S, E); }
            else { GEMM_PHASE(EpiWin, H, ws + WS_WIN, MTOK, INCOLS, 1024, 1024, 1024, ws) }
#endif
        }
        GRID_BAR();
        {
            PHASE_BEGIN
            const bf16* Qb = (const bf16*)(ws + WS_Q); const bf16* Kb = (const bf16*)(ws + WS_K); const bf16* Vb = (const bf16*)(ws + WS_V); bf16* Gb = (bf16*)(ws + WS_G);
            bf16* XCS = H; float* out = XW;
            const float* gn_g = ap->in[16] + l * 1024;
            PR_T0(3);
            const bool defer = G >= 64; const int mb = defer ? bid - 8 : bid, mG = defer ? G - 8 : G;
            if (defer && bid < 8) { pg8::Gemm g{(const bf16*)H, (const bf16*)(ws + WS_WIN), MTOK, INCOLS, 1024, 1024, 1024, 1 << 30, 0l}; pg8::OneOrder S{32 + bid, 33, 16};
                EpiWin E{ws}; pg8::gemm_phase<EpiWin, pg8::OneOrder, true, true>(lds, g, S, E); }
#pragma unroll 1
            for (int u = mb; u >= 0 && u < 1024 + 1024 + 512 + 128 + 64; u += mG) {
                if (u < 1024) { const int bh = u >> 4, c = u & 15;
                    PR_T0(6); ret_kv_unit(lds, Kb, Vb, ROPE, (float*)(ws + WS_KVB) + (size_t)u * 8192, bh >> 3, bh & 7, c, tid); PR_T1(6);
                } else if (u < 2048) { const int v = u - 1024, bs = v >> 3, h = v & 7;
                    PR_T0(4); ret_sample_unit(lds, Qb, Kb, Vb, Gb, ROPE, gn_g, ap->in[4] + (((size_t)l * 128 + bs) * 8 + h) * 8192, out + O_RETS + (((size_t)l * 128 + bs) * 8 + h) * 8192, bs, h, tid); PR_T1(4);
                } else if (u < 2560) { const int v = u - 2048, b = v >> 7, ti = v & 127;
                    PR_T0(5); conf_unit<16>(lds, (const bf16*)(ws + WS_CA), (const bf16*)(ws + WS_CB), XCS, ap->in[18] + l * 31 * 512, ap->in[19] + l * 512, ap->in[20] + l * 512, ap->in[21] + l * 512,
                                  nullptr, out + O_CONFP + ((size_t)l * 8 + b) * 30 * 512, b * 2048, ti * 16, 2048, tid); PR_T1(5);
                } else if (u < 2688) { const int bs = u - 2560;
                    PR_T0(5); conf_unit<8>(lds, (const bf16*)(ws + WS_CA), (const bf16*)(ws + WS_CB), XCS, ap->in[18] + l * 31 * 512, ap->in[19] + l * 512, ap->in[20] + l * 512, ap->in[21] + l * 512,
                                 ap->in[5] + ((size_t)l * 128 + bs) * 30 * 512, out + O_CONFS + ((size_t)l * 128 + bs) * 30 * 512, NPROMPT + bs * 8, 0, 8, tid); PR_T1(5);
                } else {
                    PR_T0(7); sconv_unit((const bf16*)(ws + WS_SB), (const bf16*)(ws + WS_SCC), (const bf16*)(ws + WS_SX), XCS, ap->in[23] + l * 3 * 512, ap->in[6] + (size_t)l * 128 * 2 * 512,
                               out + O_SCP + (size_t)l * 8 * 2 * 512, out + O_SCS + (size_t)l * 128 * 2 * 512, 1024 + (u - 2688), tid); PR_T1(7);
                }
            }
            PR_T1(3);
        }
        GRID_BAR();
        {
            PHASE_BEGIN
            PR_T0(3); ret_scan((const float*)(ws + WS_KVB), (bf16*)(ws + WS_SCB), XW + O_RETP + (size_t)l * 64 * 8192, bid * NTHREADS + tid, G * NTHREADS); PR_T1(3); }
        GRID_BAR();
        {
            PHASE_BEGIN
            const bf16* Qb = (const bf16*)(ws + WS_Q); const bf16* Kb = (const bf16*)(ws + WS_K); const bf16* Vb = (const bf16*)(ws + WS_V); bf16* Gb = (bf16*)(ws + WS_G);
            const float* gn_g = ap->in[16] + l * 1024;
            PR_T0(3);
            const bool dedic = G >= 64;
            const int rb = dedic ? bid - 16 : bid, rG = dedic ? G - 16 : G;
            if (rb >= 0) {
                { int u = rb; if (u < 1024) { R2Regs R; u32x4 gpre[4]; const bf16* SCB_ = (const bf16*)(ws + WS_SCB);
                    ret_out_fetch(R, Qb, Kb, Vb, Gb, ROPE, SCB_ + (size_t)u * 8192, u >> 7, (u >> 4) & 7, u & 15, tid);
#pragma unroll 1
                    for (;;) {
                        ret_out_stage(lds, R, Gb, ROPE, gpre, u >> 7, (u >> 4) & 7, u & 15, tid); __syncthreads();
                        const int u1 = u + rG; const bool h1 = u1 < 1024;
                        if (h1) ret_out_fetch(R, Qb, Kb, Vb, Gb, ROPE, SCB_ + (size_t)u1 * 8192, u1 >> 7, (u1 >> 4) & 7, u1 & 15, tid);
                        ret_out_compute(lds, Gb, gn_g, gpre, u >> 7, (u >> 4) & 7, u & 15, tid);
                        if (!h1) break; u = u1; } } }
#pragma unroll 1
                for (int v = 512 + rb; v < 1024; v += rG) { const int b = v >> 7, ti = v & 127;
                    conf_unit<16>(lds, (const bf16*)(ws + WS_CA), (const bf16*)(ws + WS_CB), H, ap->in[18] + l * 31 * 512, ap->in[19] + l * 512, ap->in[20] + l * 512, ap->in[21] + l * 512,
                                  nullptr, XW + O_CONFP + ((size_t)l * 8 + b) * 30 * 512, b * 2048, ti * 16, 2048, tid); }
#pragma unroll 1
                for (int t = rb; t < 1024; t += rG)
                    sconv_unit((const bf16*)(ws + WS_SB), (const bf16*)(ws + WS_SCC), (const bf16*)(ws + WS_SX), H, ap->in[23] + l * 3 * 512, ap->in[6] + (size_t)l * 128 * 2 * 512,
                               XW + O_SCP + (size_t)l * 8 * 2 * 512, XW + O_SCS + (size_t)l * 128 * 2 * 512, t, tid); }
            PR_T1(3);
            if (!dedic || bid < 16) {
                pg8::Gemm g{(const bf16*)H, (const bf16*)(ws + WS_WBR), MTOK, DM, 2048, 1024, 2048, 16, (long)((const char*)(ws + WS_G) - (const char*)H) - 16l * 128l};
                pg8::ChainOrder S; S.init(64, 4, DM, dedic ? 16 : G, bid);
                EpiBranch3 E{(const bf16*)(ws + WS_GL), ap->in[15] + l * 3072, (bf16*)(ws + WS_MBF)};
                pg8::gemm_phase<EpiBranch3, pg8::ChainOrder, true, true>(lds, g, S, E); } }
        GRID_BAR();
        {   PHASE_BEGIN
            pg8::Gemm g{(const bf16*)H, (const bf16*)(ws + WS_WBR), MTOK, DM, 2048, 1024, 2048, 16, (long)((const char*)(ws + WS_G) - (const char*)H) - 16l * 128l};
            pg8::ChainOrder S; S.init(0, 64, DM, G, bid);
            EpiBranch3 E{(const bf16*)(ws + WS_GL), ap->in[15] + l * 3072, (bf16*)(ws + WS_MBF)};
            pg8::gemm_phase<EpiBranch3, pg8::ChainOrder, true, true>(lds, g, S, E); }
        GRID_BAR();
        {   PHASE_BEGIN
            const float* ada_l = ADA + (size_t)l * NSEQ * NADA;
#if PHASES & 4
            GEMM_PHASE_SPLIT(EpiResid, ws + WS_MBF, ws + WS_WO, DM, 1024, 1024, 1024, 4, XW, (float*)ws, l * NSEQ * NADA + 5 * 1024, 1.0f, 16, 0l)
#endif
        }
        GRID_BAR();
        {   PHASE_BEGIN
            const float* ada_l = ADA + (size_t)l * NSEQ * NADA;
            PR_T0(2); rmsmod_phase(XW, XW + (size_t)NPROMPT * DM, nullptr, ap->in[26] + l * DM, ada_l, 6, H, (const float*)(ws + WS_KVB), 4, gw, NGW, lane); PR_T1(2); }
        GRID_BAR();
        {   PHASE_BEGIN
#if PHASES & 2
            GEMM_PHASE(EpiSwiglu, H, ws + WS_W13B, MTOK, 2 * DFF, 1024, 1024, 1024, U)
#ifdef PROBE_UP
            GEMM_PHASE(EpiSwiglu, H, ws + WS_W13B, MTOK, 2 * DFF, 1024, 1024, 1024, U)
#endif
#endif
        }
        GRID_BAR();
        {   PHASE_BEGIN
            const float* ada_l = ADA + (size_t)l * NSEQ * NADA;
#if PHASES & 4
            GEMM_PHASE_SPLIT(EpiResid, U, ws + WS_W2B, DM, DFF, DFF, DFF, 4, XW, (float*)ws, l * NSEQ * NADA + 8 * 1024, 0.5f, DFF / 64, 0l)
#endif
            __syncthreads();
            if (l == 0) { if (G >= 128) { if (bid >= 64) convert_layer_main(ap, ws, 1, lds, (bid - 64) * NWAVES + wave, (G - 64) * NWAVES, wave, lane); }
                          else convert_layer_main(ap, ws, 1, lds, gw, NGW, wave, lane); }
        }
        GRID_BAR();
    }
#ifdef PROBE_SYNC
#pragma unroll 1
    for (int q = 0; q < 32; ++q) GRID_BAR();
#endif
    {   PHASE_BEGIN
        PR_T0(2); final_norm_phase(XW, ap->in[30], (const float*)(ws + WS_KVB), 4, gw, NGW, lane); PR_T1(2);
#ifdef PROBE_CAT
        if (bid0 == 0) { const unsigned long long t0_ = __builtin_amdgcn_s_memrealtime(); while (__builtin_amdgcn_s_memrealtime() - t0_ < pr_acc) __builtin_amdgcn_s_sleep(8); }
#endif
    }
}

extern "C" void kernel_launch(void* const* d_in, const int* in_sizes, int n_in, void* d_out, int out_size, void* d_ws, size_t ws_size, hipStream_t stream) {
    static int grid = 0;
    if (grid == 0) {
        if (n_in != 31 || out_size != (int)O_END || ws_size < WS_END) { fprintf(stderr, "kernel_launch: unexpected shapes (n_in %d, out %d, ws %zu)\n", n_in, out_size, ws_size); grid = -1; return; }
        int dev = 0, cus = 0, per_cu = 0;
        if (hipGetDevice(&dev) != hipSuccess || hipDeviceGetAttribute(&cus, hipDeviceAttributeMultiprocessorCount, dev) != hipSuccess) { grid = -1; return; }
        if (hipFuncSetAttribute((const void*)mega_fwd, hipFuncAttributeMaxDynamicSharedMemorySize, LDS_BYTES) != hipSuccess) { fprintf(stderr, "kernel_launch: hipFuncSetAttribute failed\n"); grid = -1; return; }
        if (hipOccupancyMaxActiveBlocksPerMultiprocessor(&per_cu, (const void*)mega_fwd, NTHREADS, LDS_BYTES) != hipSuccess || per_cu < 1) { fprintf(stderr, "kernel_launch: occupancy query failed (%d)\n", per_cu); (void)hipGetLastError(); grid = -1; return; }
        grid = cus * per_cu;
        if (grid < 128) { fprintf(stderr, "kernel_launch: grid %d too small\n", grid); grid = -1; return; }
    }
    if (grid < 0) return;
    Args a{};
    for (int i = 0; i < 31; ++i) a.in[i] = (const float*)d_in[i];
    a.out = (float*)d_out; a.ws = (unsigned char*)d_ws;
    if (hipMemsetAsync((char*)d_ws + WS_BAR, 0, WS_BAR_BYTES, stream) != hipSuccess) { fprintf(stderr, "kernel_launch: memset failed\n"); return; }
    void* args[] = {&a};
    hipError_t e = hipLaunchCooperativeKernel((const void*)mega_fwd, dim3(grid), dim3(NTHREADS), args, LDS_BYTES, stream);
    if (e != hipSuccess) fprintf(stderr, "kernel_launch: cooperative launch failed: %s (grid %d)\n", hipGetErrorString(e), grid);
}
```
